# Optimizing an MI355X kernel written in HIP

```python
import math
import jax, jax.numpy as jnp
from jax import lax
import numpy as np

D_MODEL = 1024
BATCH = 4
SEQ = 4096
DEPTH = 1

HEAD_DIM = 64
NSA_HEADS = 8
NSA_KV_GROUPS = 2
NSA_REP = NSA_HEADS // NSA_KV_GROUPS
CMP_BLOCK = 32
CMP_STRIDE = 16
CMP_HIDDEN = 128
SLC_BLOCK = 64
SLC_TOP = 16
NSA_WINDOW = 512
NSA_QBLOCK = 64
FORCE_SCORE = 1.0e4
DIL_CONFIGS = ((128, 1), (512, 4), (2048, 16))
DIL_GROUPS = 3
DIL_HEADS_PER_GROUP = 4
DIL_HEADS = DIL_GROUPS * DIL_HEADS_PER_GROUP
DIL_QBLOCK = 128
D_FF = 2816
CONV_WIDTH = 3
RMS_EPS = 1e-6
NEG_INF = -1e30
D_IN = (NSA_HEADS * HEAD_DIM + 6 * NSA_KV_GROUPS * HEAD_DIM + 3 * NSA_HEADS
        + 3 * DIL_HEADS * HEAD_DIM + 2 * D_MODEL)

kernel_name = "hybrid_nsa_dilated_gated_merge"


def rmsnorm(x, g):
    xf = x.astype(jnp.float32)
    y = xf * lax.rsqrt(jnp.mean(xf * xf, axis=-1, keepdims=True) + RMS_EPS)
    return (y * g.astype(jnp.float32)).astype(x.dtype)


def alibi_slopes(n):
    return jnp.asarray(2.0 ** (-8.0 * np.arange(1, n + 1) / n), dtype=jnp.float32)


def masked_softmax(s, mask):
    s = jnp.where(mask, s.astype(jnp.float32), NEG_INF)
    m = jnp.max(s, axis=-1, keepdims=True)
    p = jnp.where(mask, jnp.exp(s - m), 0.0)
    denom = jnp.sum(p, axis=-1, keepdims=True)
    probs = p / jnp.maximum(denom, 1e-30)
    return probs, m + jnp.log(denom)


def in_splits():
    sizes = (NSA_HEADS * HEAD_DIM, 6 * NSA_KV_GROUPS * HEAD_DIM, 3 * NSA_HEADS,
             3 * DIL_HEADS * HEAD_DIM)
    idx, acc = [], 0
    for s in sizes:
        acc += s
        idx.append(acc)
    return idx


def compress(kv, pe, w1, w2):
    B, S, G, dh = kv.shape
    b16 = kv.reshape(B, S // CMP_STRIDE, CMP_STRIDE, G, dh)
    blocks = jnp.concatenate([b16[:, :-1], b16[:, 1:]], axis=2)
    blocks = blocks + pe[None, None, :, None, :]
    nc = blocks.shape[1]
    flat = blocks.transpose(0, 1, 3, 2, 4).reshape(B, nc, G, CMP_BLOCK * dh)
    return jax.nn.gelu(flat @ w1) @ w2


def nsa_attention(q, kc, vc, ks, vs, kw, vw, gates):
    B, S, H, dh = q.shape
    G, R, QB, W, L = NSA_KV_GROUPS, NSA_REP, NSA_QBLOCK, NSA_WINDOW, SLC_BLOCK
    NC = kc.shape[1]
    NS = S // L
    NQ = S // QB
    top = min(SLC_TOP, NS)
    scale = dh ** -0.5
    slopes = alibi_slopes(H).reshape(G, R)
    cmp_start = jnp.arange(NC) * CMP_STRIDE
    cmp_end = cmp_start + CMP_BLOCK - 1
    slc_start = jnp.arange(NS) * L
    overlap = jnp.clip(jnp.minimum(cmp_start[:, None] + CMP_BLOCK, slc_start[None, :] + L)
                       - jnp.maximum(cmp_start[:, None], slc_start[None, :]), 0, None)
    overlap = overlap.astype(jnp.float32) / CMP_BLOCK
    kc_t = kc.transpose(0, 2, 1, 3)
    vc_t = vc.transpose(0, 2, 1, 3)
    ks_blk = ks.reshape(B, NS, L, G, dh).transpose(0, 3, 1, 2, 4)
    vs_blk = vs.reshape(B, NS, L, G, dh).transpose(0, 3, 1, 2, 4)
    kw_pad = jnp.pad(kw, ((0, 0), (W, 0), (0, 0), (0, 0)))
    vw_pad = jnp.pad(vw, ((0, 0), (W, 0), (0, 0), (0, 0)))
    bi = jnp.arange(B)[:, None, None, None]
    gi = jnp.arange(G)[None, :, None, None]
    blk = jnp.arange(NS)

    def block_fn(i):
        q0 = i * QB
        t = q0 + jnp.arange(QB)
        qb = lax.dynamic_slice_in_dim(q, q0, QB, axis=1)
        qb = qb.reshape(B, QB, G, R, dh).transpose(0, 2, 3, 1, 4) * scale
        gb = lax.dynamic_slice_in_dim(gates, q0, QB, axis=1)
        gb = gb.reshape(B, QB, G, R, 3).transpose(0, 2, 3, 1, 4)

        d_cmp = (t[:, None] - cmp_end[None, :]).astype(jnp.float32)
        s = jnp.einsum('bgrqd,bgcd->bgrqc', qb, kc_t).astype(jnp.float32)
        s = s - slopes[None, :, :, None, None] * d_cmp
        p_cmp, _ = masked_softmax(s, d_cmp >= 0)
        o_cmp = jnp.einsum('bgrqc,bgcd->bgrqd', p_cmp.astype(vc.dtype), vc_t)

        imp = jnp.einsum('bgrqc,cs->bgqs', p_cmp, overlap)
        cur = t // L
        imp = jnp.where((blk[None, :] == cur[:, None]) | (blk[None, :] == 0), FORCE_SCORE, imp)
        imp = jnp.where(blk[None, :] <= cur[:, None], imp, -1.0)
        top_val, top_idx = lax.top_k(imp, top)
        k_sel = ks_blk[bi, gi, top_idx]
        v_sel = vs_blk[bi, gi, top_idx]
        pos = top_idx[..., None] * L + jnp.arange(L)
        d_sel = t[None, None, :, None, None] - pos
        m_sel = ((top_val >= 0)[..., None] & (d_sel >= 0))[:, :, None]
        s = jnp.einsum('bgrqd,bgqtld->bgrqtl', qb, k_sel).astype(jnp.float32)
        s = s - slopes[None, :, :, None, None, None] * d_sel[:, :, None].astype(jnp.float32)
        p_sel, _ = masked_softmax(s.reshape(B, G, R, QB, top * L), m_sel.reshape(B, G, 1, QB, top * L))
        o_sel = jnp.einsum('bgrqtl,bgqtld->bgrqd',
                           p_sel.reshape(B, G, R, QB, top, L).astype(vs.dtype), v_sel)

        kwb = lax.dynamic_slice_in_dim(kw_pad, q0, QB + W, axis=1)
        vwb = lax.dynamic_slice_in_dim(vw_pad, q0, QB + W, axis=1)
        key_pos = q0 - W + jnp.arange(QB + W)
        d_win = t[:, None] - key_pos[None, :]
        m_win = (d_win >= 0) & (d_win < W) & (key_pos[None, :] >= 0)
        s = jnp.einsum('bgrqd,bkgd->bgrqk', qb, kwb).astype(jnp.float32)
        s = s - slopes[None, :, :, None, None] * d_win.astype(jnp.float32)
        p_win, _ = masked_softmax(s, m_win)
        o_win = jnp.einsum('bgrqk,bkgd->bgrqd', p_win.astype(vw.dtype), vwb)

        o = gb[..., 0:1] * o_cmp + gb[..., 1:2] * o_sel + gb[..., 2:3] * o_win
        return o.transpose(0, 3, 1, 2, 4).reshape(B, QB, H * dh)

    out = lax.map(block_fn, jnp.arange(NQ))
    return out.transpose(1, 0, 2, 3).reshape(B, S, H * dh)


def dilated_attention(q, k, v):
    B, S, NG, HG, dh = q.shape
    QB = DIL_QBLOCK
    NQ = S // QB
    scale = dh ** -0.5
    slopes = alibi_slopes(DIL_HEADS).reshape(NG, HG)

    def block_fn(i):
        q0 = i * QB
        t = q0 + jnp.arange(QB)
        qb = lax.dynamic_slice_in_dim(q, q0, QB, axis=1) * scale
        outs, lses = [], []
        for g, (w, r) in enumerate(DIL_CONFIGS):
            dist = r * jnp.arange(w // r + 1)
            key_pos = t[:, None] - dist[None, :]
            idx = jnp.maximum(key_pos, 0)
            kg = jnp.take(k[:, :, g], idx, axis=1)
            vg = jnp.take(v[:, :, g], idx, axis=1)
            s = jnp.einsum('bqhd,bqnhd->bhqn', qb[:, :, g], kg).astype(jnp.float32)
            s = s - slopes[g][:, None, None] * dist.astype(jnp.float32)
            p, lse = masked_softmax(s, (key_pos >= 0)[None, None])
            outs.append(jnp.einsum('bhqn,bqnhd->bqhd', p.astype(v.dtype), vg))
            lses.append(lse[..., 0])
        wts = jax.nn.softmax(jnp.stack(lses, axis=0), axis=0)
        o = outs[0] * wts[0].transpose(0, 2, 1)[..., None].astype(outs[0].dtype)
        for g in range(1, NG):
            o = o + outs[g] * wts[g].transpose(0, 2, 1)[..., None].astype(outs[g].dtype)
        return o.reshape(B, QB, HG * dh)

    out = lax.map(block_fn, jnp.arange(NQ))
    return out.transpose(1, 0, 2, 3).reshape(B, S, HG * dh)


def conv_ffn(h, w_up, conv_w, conv_b, w_down):
    S = h.shape[1]
    u, gate = jnp.split(h @ w_up, 2, axis=-1)
    up = jnp.pad(u, ((0, 0), (CONV_WIDTH - 1, 0), (0, 0)))
    uc = conv_b
    for j in range(CONV_WIDTH):
        uc = uc + conv_w[j] * up[:, j:j + S]
    return (jax.nn.gelu(uc) * gate) @ w_down


def setup_inputs(seed: int = 0) -> dict:
    key = jax.random.key(seed)
    ks = jax.random.split(key, 20)
    f = jnp.float32
    dh = HEAD_DIM

    def nrm(k, shape, scale):
        return jax.random.normal(k, shape, f) * scale

    return {
        "x": jax.random.normal(ks[0], (BATCH, SEQ, D_MODEL), f),
        "g_mix": 1.0 + nrm(ks[1], (DEPTH, D_MODEL), 0.01),
        "w_in": nrm(ks[2], (DEPTH, D_MODEL, D_IN), D_MODEL ** -0.5),
        "pe_cmp_k": nrm(ks[3], (DEPTH, CMP_BLOCK, dh), 0.1),
        "w_cmp_k1": nrm(ks[4], (DEPTH, CMP_BLOCK * dh, CMP_HIDDEN), (CMP_BLOCK * dh) ** -0.5),
        "w_cmp_k2": nrm(ks[5], (DEPTH, CMP_HIDDEN, dh), CMP_HIDDEN ** -0.5),
        "pe_cmp_v": nrm(ks[6], (DEPTH, CMP_BLOCK, dh), 0.1),
        "w_cmp_v1": nrm(ks[7], (DEPTH, CMP_BLOCK * dh, CMP_HIDDEN), (CMP_BLOCK * dh) ** -0.5),
        "w_cmp_v2": nrm(ks[8], (DEPTH, CMP_HIDDEN, dh), CMP_HIDDEN ** -0.5),
        "w_proj_nsa": nrm(ks[9], (DEPTH, NSA_HEADS * dh, D_MODEL), (NSA_HEADS * dh) ** -0.5),
        "w_proj_dil": nrm(ks[10], (DEPTH, DIL_HEADS_PER_GROUP * dh, D_MODEL), (DIL_HEADS_PER_GROUP * dh) ** -0.5),
        "w_out": nrm(ks[11], (DEPTH, D_MODEL, D_MODEL), D_MODEL ** -0.5),
        "g_ffn": 1.0 + nrm(ks[12], (DEPTH, D_MODEL), 0.01),
        "w_up": nrm(ks[13], (DEPTH, D_MODEL, 2 * D_FF), D_MODEL ** -0.5),
        "conv_w": nrm(ks[14], (DEPTH, CONV_WIDTH, D_FF), CONV_WIDTH ** -0.5),
        "conv_b": nrm(ks[15], (DEPTH, D_FF), 0.01),
        "w_down": nrm(ks[16], (DEPTH, D_FF, D_MODEL), D_FF ** -0.5),
        "g_final": 1.0 + nrm(ks[17], (D_MODEL,), 0.01),
    }


def reference(x, g_mix, w_in, pe_cmp_k, w_cmp_k1, w_cmp_k2, pe_cmp_v, w_cmp_v1, w_cmp_v2,
              w_proj_nsa, w_proj_dil, w_out, g_ffn, w_up, conv_w, conv_b, w_down, g_final):
    B, S, _ = x.shape
    G, dh = NSA_KV_GROUPS, HEAD_DIM
    for l in range(DEPTH):
        h = rmsnorm(x, g_mix[l])
        proj = h @ w_in[l]
        q_a, kv_a, gate_a, qkv_b, merge_logits = jnp.split(proj, in_splits(), axis=-1)
        q_a = q_a.reshape(B, S, NSA_HEADS, dh)
        kv_a = kv_a.reshape(B, S, 6, G, dh)
        kc = compress(kv_a[:, :, 0], pe_cmp_k[l], w_cmp_k1[l], w_cmp_k2[l])
        vc = compress(kv_a[:, :, 1], pe_cmp_v[l], w_cmp_v1[l], w_cmp_v2[l])
        gate_a = jax.nn.sigmoid(gate_a).reshape(B, S, NSA_HEADS, 3)
        o_a = nsa_attention(q_a, kc, vc, kv_a[:, :, 2], kv_a[:, :, 3], kv_a[:, :, 4], kv_a[:, :, 5], gate_a)
        qkv_b = qkv_b.reshape(B, S, 3, DIL_GROUPS, DIL_HEADS_PER_GROUP, dh)
        o_b = dilated_attention(qkv_b[:, :, 0], qkv_b[:, :, 1], qkv_b[:, :, 2])
        gate_m = jax.nn.sigmoid(merge_logits)
        mixed = gate_m[..., :D_MODEL] * (o_a @ w_proj_nsa[l]) + gate_m[..., D_MODEL:] * (o_b @ w_proj_dil[l])
        x = x + mixed @ w_out[l]
        h = rmsnorm(x, g_ffn[l])
        x = x + conv_ffn(h, w_up[l], conv_w[l], conv_b[l], w_down[l])
    return rmsnorm(x, g_final)
```

```cpp
#include <hip/hip_runtime.h>
#include <hip/hip_cooperative_groups.h>
#include <cstdio>
#include <cstdint>
namespace cg = cooperative_groups;

#define LAS __attribute__((address_space(3)))
#define DI __device__ __forceinline__
typedef unsigned short bf16_t;
typedef short bf16x8 __attribute__((ext_vector_type(8)));
typedef short s16x4 __attribute__((ext_vector_type(4)));
typedef float f32x4 __attribute__((ext_vector_type(4)));
typedef float f32x2 __attribute__((ext_vector_type(2)));
typedef float f32x16 __attribute__((ext_vector_type(16)));
typedef unsigned u32x4 __attribute__((ext_vector_type(4)));
typedef unsigned u32x2 __attribute__((ext_vector_type(2)));
typedef __bf16 bf16x2v __attribute__((ext_vector_type(2)));

constexpr int B_ = 4, S_ = 4096, D_ = 1024, T_ = B_ * S_;
constexpr int NIN = 5888;
constexpr int NINSRC = 5656;
constexpr int DFF = 2816, NUP = 5632;
constexpr float RMS_EPS = 1e-6f;
constexpr float LOG2E = 1.4426950408889634f, LN2 = 0.6931471805599453f;

constexpr size_t MiB = 1u << 20;
constexpr size_t WS_WIN = 0;
constexpr size_t WS_WUP = WS_WIN + (size_t)NIN * 1024 * 2;
constexpr size_t WS_WDN = WS_WUP + (size_t)NUP * 1024 * 2;
constexpr size_t WS_WOUT = WS_WDN + (size_t)1024 * DFF * 2;
constexpr size_t WS_WPN = WS_WOUT + (size_t)1024 * 1024 * 2;
constexpr size_t WS_WPD = WS_WPN + (size_t)1024 * 512 * 2;
constexpr size_t WS_W1K = WS_WPD + (size_t)1024 * 256 * 2;
constexpr size_t WS_W1V = WS_W1K + (size_t)128 * 2048 * 2;
constexpr size_t WS_W2K = WS_W1V + (size_t)128 * 2048 * 2;
constexpr size_t WS_W2V = WS_W2K + (size_t)64 * 128 * 2;
constexpr size_t WS_WEND = WS_W2V + (size_t)64 * 128 * 2;
constexpr size_t WS_R1 = 33 * MiB;
constexpr size_t WS_PJQ = WS_R1, WS_PJKV = WS_R1 + 16 * MiB, WS_PJB = WS_R1 + 40 * MiB, WS_PJM = WS_R1 + 112 * MiB, WS_PJG = WS_R1 + 176 * MiB;
constexpr size_t WS_MIX = WS_R1;
constexpr size_t WS_UG = WS_R1;
constexpr size_t WS_R2 = 217 * MiB;
constexpr size_t WS_H1 = WS_R2, WS_OD = WS_R2, WS_LSE = WS_R2 + 24 * MiB, WS_A2 = WS_R2;
constexpr size_t WS_KC = 249 * MiB, WS_VC = WS_KC + 262144, WS_SSQ2 = 250 * MiB, WS_SSQ3 = 251 * MiB, WS_END = 252 * MiB;
static_assert(WS_WEND <= WS_R1, "weights");

constexpr int LDS_BYTES = 147456;
constexpr int KT_STRIDE = 144, VT_STRIDE = 136, VT_OFF = 64 * KT_STRIDE, KV_REGION = VT_OFF + 64 * VT_STRIDE;
constexpr int IMP_OFF = 73728, IMP_QS = 65, IMP_BYTES = 4 * 64 * IMP_QS * 4;
constexpr int SEL_OFF = IMP_OFF + IMP_BYTES, UNI_OFF = SEL_OFF + 512;
static_assert(UNI_OFF + 64 <= LDS_BYTES, "lds");
constexpr int HIDB_OFF = 131072, HIDB_STRIDE = 272;

struct Params {
    const float *x, *g_mix, *w_in, *pe_k, *w_k1, *w_k2, *pe_v, *w_v1, *w_v2, *w_pn, *w_pd, *w_out, *g_ffn, *w_up, *conv_w, *conv_b, *w_down, *g_final;
    float* out; unsigned char* ws; int ph_lo, ph_hi;
};

DI float bf2f(unsigned v) { return __builtin_bit_cast(float, v << 16); }
DI unsigned pk2(float a, float b) { f32x2 v = {a, b}; return __builtin_bit_cast(unsigned, __builtin_convertvector(v, bf16x2v)); }
DI float wave_sum(float v) {
#pragma unroll
    for (int o = 1; o < 64; o <<= 1) v += __shfl_xor(v, o, 64);
    return v;
}
DI float fexp2(float x) { return __builtin_amdgcn_exp2f(x); }
DI float sigmoidf_(float x) { return 1.0f / (1.0f + __expf(-x)); }
DI float gelu_tanh(float x) {
    const float y = 0.7978845608028654f * (x + 0.044715f * x * x * x);
    const float e = __expf(2.0f * y);
    const float t = 1.0f - 2.0f / (e + 1.0f);
    return 0.5f * x * (1.0f + t);
}
DI int crow(int i, int h) { return (i & 3) + 8 * (i >> 2) + 4 * h; }
#define MFMA32(a, b, c) __builtin_amdgcn_mfma_f32_32x32x16_bf16((a), (b), (c), 0, 0, 0)

namespace pg8 {
constexpr int BM = 256, BK = 64, HALF = 128, HTB = HALF * BK * 2, NXCD = 8, WGM = 8;
DI int lds_byte(int r, int c) { const int st = (r >> 4) * 2 + (c >> 5), rr = r & 15, cc = c & 31, ob = rr * 64 + cc * 2; return st * 1024 + (ob ^ (((ob >> 9) & 1) << 5)); }
DI void stage_rc(int b, int& R, int& C) { const int st = b / 1024, sb = b % 1024, swz = sb ^ (((sb >> 9) & 1) << 5); R = (st >> 1) * 16 + swz / 64; C = (st & 1) * 32 + (swz % 64) / 2; }
DI int perm32(int rho) { const int n = rho >> 4, i = rho & 15; return 8 * (i >> 2) + 4 * n + (i & 3); }
struct Unit { int pm, pn; };
struct Gemm { const bf16_t* A; const bf16_t* Bt; int M, N, K, lda, apair; };
struct StaticOrder {
    int nM, nN, nwg, G, c;
    DI void init(int M, int N, int G_, int c_) { nM = M / BM; nN = N / BM; nwg = nM * nN; G = G_; c = c_; }
    DI bool next(int i, Unit& u) const {
        const long L = (long)i * G + c; if (L >= nwg) return false;
        int wgid = (int)L; { const int q = nwg / NXCD, r = nwg % NXCD, xcd = wgid % NXCD, off = wgid / NXCD; wgid = (xcd < r ? xcd * (q + 1) : r * (q + 1) + (xcd - r) * q) + off; }
        const int nig = WGM * nN, gid = wgid / nig, fm = gid * WGM, gsz = (nM - fm) < WGM ? (nM - fm) : WGM;
        u.pm = fm + ((wgid % nig) % gsz); u.pn = (wgid % nig) / gsz; return true;
    }
};
template <class Epi>
DI void gemm_phase(LAS unsigned char* lds, const Gemm g, const StaticOrder& S, const Epi& E) {
    const int tid = threadIdx.x, wid = __builtin_amdgcn_readfirstlane(tid >> 6), lane = tid & 63, wr = wid >> 2, wc = wid & 3, fr = lane & 15, fq = lane >> 4;
    const int K = g.K, nt = K / BK, lda = g.lda;
    unsigned voffA[2], voffB[2];
#pragma unroll
    for (int i = 0; i < 2; ++i) { int R, C; stage_rc(tid * 16 + i * 8192, R, C); const int Rb = (R & ~31) + perm32(R & 31);
        voffA[i] = (unsigned)(R * lda + C) * 2u; voffB[i] = (unsigned)(Rb * K + C) * 2u; }
    const size_t kstep = (size_t)(BK * 2);
    const size_t apairB = (size_t)g.apair * 2;
    const size_t hstepA = (size_t)HALF * lda * 2, tstepA = 2 * hstepA;
    const size_t hstepB = (size_t)HALF * K * 2, tstepB = 2 * hstepB;
    const unsigned ldsw = (unsigned)wid * 1024u;
    const int aoff = lds_byte(wr * 64 + fr, fq * 8), boff = lds_byte(wc * 32 + fr, fq * 8);
#define PG8_SA(b, h) (((b) * 2 + (h)) * HTB)
#define PG8_SB(b, h) ((4 + (b) * 2 + (h)) * HTB)
#define PG8_STAGE(bufoff, gbase, voff) do { _Pragma("unroll") for (int _i = 0; _i < 2; ++_i) \
        __builtin_amdgcn_global_load_lds((const unsigned*)((const char*)(gbase) + (voff)[_i]), (LAS unsigned*)(lds + (bufoff) + ldsw + _i * 8192), 16, 0, 0); } while (0)
#define PG8_LDA(dst, b, h) do { _Pragma("unroll") for (int m = 0; m < 4; ++m) _Pragma("unroll") for (int k = 0; k < 2; ++k) dst[m][k] = *(const LAS bf16x8*)(lds + PG8_SA(b, h) + aoff + m * 2048 + k * 1024); } while (0)
#define PG8_LDB(dst, b, h) do { _Pragma("unroll") for (int n = 0; n < 2; ++n) _Pragma("unroll") for (int k = 0; k < 2; ++k) dst[n][k] = *(const LAS bf16x8*)(lds + PG8_SB(b, h) + boff + n * 2048 + k * 1024); } while (0)
#define PG8_MMA(ai, bj, At, Bt) do { __builtin_amdgcn_s_setprio(1); _Pragma("unroll") for (int m = 0; m < 4; ++m) _Pragma("unroll") for (int n = 0; n < 2; ++n) _Pragma("unroll") for (int k = 0; k < 2; ++k) \
        acc[ai][bj][m][n] = __builtin_amdgcn_mfma_f32_16x16x32_bf16(Bt[n][k], At[m][k], acc[ai][bj][m][n], 0, 0, 0); __builtin_amdgcn_s_setprio(0); } while (0)
#define PG8_WAIT_V(n) asm volatile("s_waitcnt vmcnt(" #n ")" ::: "memory")
#define PG8_WAIT_L(n) asm volatile("s_waitcnt lgkmcnt(" #n ")" ::: "memory")
#define PG8_BAR __builtin_amdgcn_s_barrier()
#define PG8_SCHED __builtin_amdgcn_sched_barrier(0)
    Unit cur, nxt; int ui = 0;
    if (!S.next(0, cur)) return;
    f32x4 acc[2][2][4][2];
#pragma unroll
    for (int a = 0; a < 2; ++a)
#pragma unroll
        for (int b = 0; b < 2; ++b)
#pragma unroll
            for (int m = 0; m < 4; ++m)
#pragma unroll
                for (int n = 0; n < 2; ++n) acc[a][b][m][n] = (f32x4){0.f, 0.f, 0.f, 0.f};
    bf16x8 At[4][2], B0[2][2], B1[2][2];
    const char* cA = (const char*)g.A + (size_t)cur.pm * tstepA; const char* cB = (const char*)g.Bt + (size_t)cur.pn * tstepB;
    PG8_STAGE(PG8_SB(0, 0), cB, voffB); PG8_STAGE(PG8_SB(0, 1), cB + hstepB, voffB); PG8_STAGE(PG8_SA(0, 0), cA, voffA); PG8_STAGE(PG8_SA(0, 1), cA + hstepA, voffA);
    if (wr == 1) PG8_BAR;
    PG8_WAIT_V(2); PG8_BAR;
    PG8_STAGE(PG8_SB(1, 0), cB + kstep, voffB); PG8_STAGE(PG8_SA(1, 0), cA + kstep, voffA); PG8_STAGE(PG8_SB(1, 1), cB + hstepB + kstep, voffB);
    PG8_WAIT_V(6); PG8_BAR;
    for (;;) {
        const bool has_next = S.next(ui + 1, nxt);
        const char* nA = has_next ? (const char*)g.A + (size_t)nxt.pm * tstepA : cA; const char* nB = has_next ? (const char*)g.Bt + (size_t)nxt.pn * tstepB : cB;
        for (int t = 0; t < nt; t += 2) {
            const bool last = (t == nt - 2);
            const char* a1 = cA + (size_t)(t >> 1) * apairB + kstep;
            const char* a2 = last ? nA : cA + (size_t)((t >> 1) + 1) * apairB; const char* b2 = last ? nB : cB + (size_t)(t + 2) * kstep;
            const char* a3 = a2 + kstep; const char* b3 = b2 + kstep;
            PG8_LDB(B0, 0, 0); PG8_LDB(B1, 0, 1); PG8_SCHED; PG8_LDA(At, 0, 0); PG8_STAGE(PG8_SA(1, 1), a1 + hstepA, voffA);
            PG8_WAIT_V(8); PG8_WAIT_L(0); PG8_BAR; PG8_MMA(0, 0, At, B0); PG8_MMA(0, 1, At, B1); PG8_BAR; PG8_SCHED;
            PG8_LDA(At, 0, 1); PG8_STAGE(PG8_SB(0, 0), b2, voffB); PG8_STAGE(PG8_SB(0, 1), b2 + hstepB, voffB); PG8_STAGE(PG8_SA(0, 0), a2, voffA);
            PG8_WAIT_V(8); PG8_WAIT_L(0); PG8_BAR; PG8_MMA(1, 0, At, B0); PG8_MMA(1, 1, At, B1); PG8_BAR; PG8_SCHED;
            PG8_LDB(B0, 1, 0); PG8_LDB(B1, 1, 1); PG8_SCHED; PG8_LDA(At, 1, 0); PG8_STAGE(PG8_SA(0, 1), a2 + hstepA, voffA);
            PG8_WAIT_V(8); PG8_WAIT_L(0); PG8_BAR; PG8_MMA(0, 0, At, B0); PG8_MMA(0, 1, At, B1); PG8_BAR; PG8_SCHED;
            PG8_LDA(At, 1, 1); PG8_STAGE(PG8_SB(1, 0), b3, voffB); PG8_STAGE(PG8_SB(1, 1), b3 + hstepB, voffB); PG8_STAGE(PG8_SA(1, 0), a3, voffA);
            PG8_WAIT_V(8); PG8_WAIT_L(0); PG8_BAR; PG8_MMA(1, 0, At, B0); PG8_MMA(1, 1, At, B1); PG8_BAR; PG8_SCHED;
        }
        if (wr == 0) PG8_BAR;
        E(acc, cur, wr, wc, fr, fq);
        if (!has_next) break;
#pragma unroll
        for (int a = 0; a < 2; ++a)
#pragma unroll
            for (int b = 0; b < 2; ++b)
#pragma unroll
                for (int m = 0; m < 4; ++m)
#pragma unroll
                    for (int n = 0; n < 2; ++n) acc[a][b][m][n] = (f32x4){0.f, 0.f, 0.f, 0.f};
        cur = nxt; cA = nA; cB = nB; ++ui;
        if (wr == 1) PG8_BAR;
    }
    PG8_WAIT_V(0);
    PG8_BAR;
#undef PG8_SA
#undef PG8_SB
#undef PG8_STAGE
#undef PG8_LDA
#undef PG8_LDB
#undef PG8_MMA
#undef PG8_WAIT_V
#undef PG8_WAIT_L
#undef PG8_BAR
#undef PG8_SCHED
}
typedef f32x4 Acc[2][2][4][2];
DI void store8(bf16_t* p, f32x4 v0, f32x4 v1) { u32x4 w; w.x = pk2(v0[0], v0[1]); w.y = pk2(v0[2], v0[3]); w.z = pk2(v1[0], v1[1]); w.w = pk2(v1[2], v1[3]); *(u32x4*)p = w; }
DI void load8(const bf16_t* p, f32x4& v0, f32x4& v1) { const u32x4 w = *(const u32x4*)p;
    v0 = (f32x4){bf2f(w.x & 0xffffu), bf2f(w.x >> 16), bf2f(w.y & 0xffffu), bf2f(w.y >> 16)}; v1 = (f32x4){bf2f(w.z & 0xffffu), bf2f(w.z >> 16), bf2f(w.w & 0xffffu), bf2f(w.w >> 16)}; }

struct EpiProj {
    unsigned char* ws;
    DI void operator()(const Acc& acc, const Unit& u, int wr, int wc, int fr, int fq) const {
        const int pn = u.pn; bf16_t* base; int ld, ct;
        if (pn < 2) { base = (bf16_t*)(ws + WS_PJQ); ld = 512; ct = pn; }
        else if (pn < 5) { base = (bf16_t*)(ws + WS_PJKV); ld = 768; ct = pn - 2; }
        else if (pn < 14) { base = (bf16_t*)(ws + WS_PJB); ld = 2304; ct = pn - 5; }
        else if (pn < 22) { base = (bf16_t*)(ws + WS_PJM); ld = 2048; ct = pn - 14; }
        else { base = (bf16_t*)(ws + WS_PJG); ld = 256; ct = 0; }
        const int row0 = u.pm * BM + wr * 64 + fr, col0 = ct * 256 + wc * 32 + 8 * fq;
#pragma unroll
        for (int ai = 0; ai < 2; ++ai)
#pragma unroll
            for (int m = 0; m < 4; ++m) { bf16_t* rowp = base + (size_t)(row0 + ai * HALF + m * 16) * ld + col0;
#pragma unroll
                for (int bj = 0; bj < 2; ++bj) store8(rowp + bj * HALF, acc[ai][bj][m][0], acc[ai][bj][m][1]); }
    }
};
template <int SECOND> struct EpiMerge {
    const bf16_t* gate; bf16_t* mix;
    DI void operator()(const Acc& acc, const Unit& u, int wr, int wc, int fr, int fq) const {
        const int row0 = u.pm * BM + wr * 64 + fr, col0 = u.pn * BM + wc * 32 + 8 * fq;
#pragma unroll
        for (int ai = 0; ai < 2; ++ai)
#pragma unroll
            for (int m = 0; m < 4; ++m) { const size_t row = (size_t)(row0 + ai * HALF + m * 16);
#pragma unroll
                for (int bj = 0; bj < 2; ++bj) { const int col = col0 + bj * HALF;
                    f32x4 g0, g1; load8(gate + row * 2048 + SECOND * 1024 + col, g0, g1);
                    f32x4 v0 = acc[ai][bj][m][0], v1 = acc[ai][bj][m][1];
#pragma unroll
                    for (int e = 0; e < 4; ++e) { v0[e] *= sigmoidf_(g0[e]); v1[e] *= sigmoidf_(g1[e]); }
                    if (SECOND) { f32x4 p0, p1; load8(mix + row * 1024 + col, p0, p1); v0 += p0; v1 += p1; }
                    store8(mix + row * 1024 + col, v0, v1); } }
    }
};
template <int WRITE_A2> struct EpiResid {
    const float* xi; float* xo; bf16_t* a2; const float* gw; float* ssq;
    DI void operator()(const Acc& acc, const Unit& u, int wr, int wc, int fr, int fq) const {
        const int row0 = u.pm * BM + wr * 64 + fr, col0 = u.pn * BM + wc * 32 + 8 * fq;
#pragma unroll
        for (int ai = 0; ai < 2; ++ai)
#pragma unroll
            for (int m = 0; m < 4; ++m) { const size_t row = (size_t)(row0 + ai * HALF + m * 16); float ss = 0.f;
#pragma unroll
                for (int bj = 0; bj < 2; ++bj) { const int col = col0 + bj * HALF;
                    const f32x4 x0 = *(const f32x4*)(xi + row * 1024 + col), x1 = *(const f32x4*)(xi + row * 1024 + col + 4);
                    const f32x4 v0 = acc[ai][bj][m][0] + x0, v1 = acc[ai][bj][m][1] + x1;
                    *(f32x4*)(xo + row * 1024 + col) = v0; *(f32x4*)(xo + row * 1024 + col + 4) = v1;
                    ss += (v0[0] * v0[0] + v0[1] * v0[1]) + (v0[2] * v0[2] + v0[3] * v0[3]) + (v1[0] * v1[0] + v1[1] * v1[1]) + (v1[2] * v1[2] + v1[3] * v1[3]);
                    if (WRITE_A2) { const f32x4 w0 = *(const f32x4*)(gw + col), w1 = *(const f32x4*)(gw + col + 4); store8(a2 + row * 1024 + col, v0 * w0, v1 * w1); } }
                ss += __shfl_xor(ss, 16, 64); ss += __shfl_xor(ss, 32, 64);
                if (fq == 0) ssq[row * 16 + u.pn * 4 + wc] = ss; }
    }
};
struct EpiUp {
    const float* ssq; bf16_t* ug;
    DI void operator()(const Acc& acc, const Unit& u, int wr, int wc, int fr, int fq) const {
        const int row0 = u.pm * BM + wr * 64 + fr, col0 = u.pn * BM + wc * 32 + 8 * fq;
#pragma unroll
        for (int ai = 0; ai < 2; ++ai)
#pragma unroll
            for (int m = 0; m < 4; ++m) { const size_t row = (size_t)(row0 + ai * HALF + m * 16);
                const f32x4* sp = (const f32x4*)(ssq + row * 16); const f32x4 s0 = sp[0], s1 = sp[1], s2 = sp[2], s3 = sp[3];
                const f32x4 st = (s0 + s1) + (s2 + s3); const float tot = (st[0] + st[1]) + (st[2] + st[3]);
                const float rstd = __builtin_amdgcn_rsqf(tot * (1.0f / 1024.0f) + RMS_EPS);
#pragma unroll
                for (int bj = 0; bj < 2; ++bj) store8(ug + row * NUP + col0 + bj * HALF, acc[ai][bj][m][0] * rstd, acc[ai][bj][m][1] * rstd); }
    }
};
}

DI int rowmap(int mode, int n) {
    if (mode == 1) { if (n < 1280) return n; if (n < 1304) return 5632 + (n - 1280); return n - 24; }
    if (mode == 2) { if (n < DFF) return (n >> 7) * 256 + (n & 127); const int q = n - DFF; return (q >> 7) * 256 + 128 + (q & 127); }
    return n;
}
DI void transpose_item(const float* W, int K, int N, bf16_t* WT, int mode, LAS float* scr, int item, int lane) {
    const int nblk = (N + 31) / 32, kb = item / nblk, nb = item % nblk, k0 = 64 * kb, n0 = 32 * nb;
    const int nl = n0 + (lane & 31);
#pragma unroll 8
    for (int i = 0; i < 32; ++i) { const int kk = 2 * i + (lane >> 5); scr[kk * 33 + (lane & 31)] = (nl < N) ? W[(size_t)(k0 + kk) * N + nl] : 0.f; }
    asm volatile("s_waitcnt lgkmcnt(0)" ::: "memory");
    const int c = lane & 7;
#pragma unroll
    for (int j = 0; j < 4; ++j) { const int n = (lane >> 3) + 8 * j; const LAS float* s = scr + (8 * c) * 33 + n;
        u32x4 o; o.x = pk2(s[0 * 33], s[1 * 33]); o.y = pk2(s[2 * 33], s[3 * 33]); o.z = pk2(s[4 * 33], s[5 * 33]); o.w = pk2(s[6 * 33], s[7 * 33]);
        if (n0 + n < N) *(u32x4*)(WT + (size_t)rowmap(mode, n0 + n) * K + k0 + 8 * c) = o; }
    asm volatile("s_waitcnt lgkmcnt(0)" ::: "memory");
}
DI void p0_prologue(const Params& P, LAS unsigned char* lds) {
    const int tid = threadIdx.x, lane = tid & 63, wave = tid >> 6;
    LAS float* scr = (LAS float*)(lds + wave * 16384);
    const int gw = blockIdx.x * 8 + wave, NGW = gridDim.x * 8;
    unsigned char* ws = P.ws;
    int base = 0;
#define DOJOB(W_, K_, N_, OFF_, MODE_) do { const int items = ((K_) / 64) * (((N_) + 31) / 32); \
        int first = gw - (base % NGW); if (first < 0) first += NGW; \
        for (int it = first; it < items; it += NGW) transpose_item((W_), (K_), (N_), (bf16_t*)(ws + (OFF_)), (MODE_), scr, it, lane); \
        base += items; } while (0)
    DOJOB(P.w_in, 1024, NINSRC, WS_WIN, 1); DOJOB(P.w_up, 1024, NUP, WS_WUP, 2); DOJOB(P.w_down, DFF, 1024, WS_WDN, 0); DOJOB(P.w_out, 1024, 1024, WS_WOUT, 0);
    DOJOB(P.w_pn, 512, 1024, WS_WPN, 0); DOJOB(P.w_pd, 256, 1024, WS_WPD, 0); DOJOB(P.w_k1, 2048, 128, WS_W1K, 0); DOJOB(P.w_v1, 2048, 128, WS_W1V, 0);
    DOJOB(P.w_k2, 128, 64, WS_W2K, 0); DOJOB(P.w_v2, 128, 64, WS_W2V, 0);
#undef DOJOB
    { u32x4* z = (u32x4*)(ws + WS_WIN + (size_t)NINSRC * 1024 * 2); const int n16 = (NIN - NINSRC) * 1024 * 2 / 16;
      for (int i = blockIdx.x * 512 + tid; i < n16; i += gridDim.x * 512) z[i] = (u32x4){0u, 0u, 0u, 0u}; }
    bf16_t* H1 = (bf16_t*)(ws + WS_H1);
    f32x4 gv[4];
#pragma unroll
    for (int j = 0; j < 4; ++j) gv[j] = ((const f32x4*)P.g_mix)[lane + 64 * j];
    for (int m = gw; m < T_; m += NGW) {
        const f32x4* xr = (const f32x4*)(P.x + (size_t)m * D_) + lane;
        f32x4 v[4]; float s = 0.f;
#pragma unroll
        for (int j = 0; j < 4; ++j) { v[j] = xr[64 * j]; s += (v[j].x * v[j].x + v[j].y * v[j].y) + (v[j].z * v[j].z + v[j].w * v[j].w); }
        const float rstd = 1.0f / sqrtf(wave_sum(s) * (1.0f / D_) + RMS_EPS);
        u32x2* o8 = (u32x2*)(H1 + (size_t)m * D_) + lane;
#pragma unroll
        for (int j = 0; j < 4; ++j) { const f32x4 y = v[j] * rstd * gv[j]; u32x2 w; w.x = pk2(y.x, y.y); w.y = pk2(y.z, y.w); o8[64 * j] = w; }
    }
}

struct AttnState { f32x16 o0, o1; float m, l; };
DI void attn_init(AttnState& st) {
#pragma unroll
    for (int i = 0; i < 16; ++i) { st.o0[i] = 0.f; st.o1[i] = 0.f; }
    st.m = -1e29f; st.l = 0.f;
}
DI void stage_kv(LAS unsigned char* kt, const bf16_t* kbase, const bf16_t* vbase, size_t rowstride, int ptid, int nthr, bool with_v) {
    for (int chunk = ptid; chunk < 512; chunk += nthr) {
        const int key = chunk >> 3, dc = chunk & 7;
        const u32x4 kv = *(const u32x4*)(kbase + (size_t)key * rowstride + dc * 8);
        *(LAS u32x4*)(kt + key * KT_STRIDE + dc * 16) = kv;
        if (with_v) {
            const u32x4 vv = *(const u32x4*)(vbase + (size_t)key * rowstride + dc * 8);
            LAS unsigned char* vt = kt + VT_OFF + (dc * 8) * VT_STRIDE + key * 2;
            *(LAS unsigned short*)(vt + 0 * VT_STRIDE) = (unsigned short)(vv.x & 0xffffu); *(LAS unsigned short*)(vt + 1 * VT_STRIDE) = (unsigned short)(vv.x >> 16);
            *(LAS unsigned short*)(vt + 2 * VT_STRIDE) = (unsigned short)(vv.y & 0xffffu); *(LAS unsigned short*)(vt + 3 * VT_STRIDE) = (unsigned short)(vv.y >> 16);
            *(LAS unsigned short*)(vt + 4 * VT_STRIDE) = (unsigned short)(vv.z & 0xffffu); *(LAS unsigned short*)(vt + 5 * VT_STRIDE) = (unsigned short)(vv.z >> 16);
            *(LAS unsigned short*)(vt + 6 * VT_STRIDE) = (unsigned short)(vv.w & 0xffffu); *(LAS unsigned short*)(vt + 7 * VT_STRIDE) = (unsigned short)(vv.w >> 16);
        }
    }
}
DI void qk_tile(const LAS unsigned char* kt, const bf16x8 (&qf)[4], int r, int h, f32x16& x0, f32x16& x1) {
#pragma unroll
    for (int i = 0; i < 16; ++i) { x0[i] = 0.f; x1[i] = 0.f; }
#pragma unroll
    for (int kk = 0; kk < 4; ++kk) {
        const bf16x8 a0 = *(const LAS bf16x8*)(kt + r * KT_STRIDE + kk * 32 + h * 16);
        const bf16x8 a1 = *(const LAS bf16x8*)(kt + (32 + r) * KT_STRIDE + kk * 32 + h * 16);
        x0 = MFMA32(a0, qf[kk], x0); x1 = MFMA32(a1, qf[kk], x1);
    }
}
DI bf16x8 pack8(const f32x16& x, int s) {
    u32x4 p; p.x = pk2(x[8 * s + 0], x[8 * s + 1]); p.y = pk2(x[8 * s + 2], x[8 * s + 3]); p.z = pk2(x[8 * s + 4], x[8 * s + 5]); p.w = pk2(x[8 * s + 6], x[8 * s + 7]);
    return __builtin_bit_cast(bf16x8, p);
}
template <class MB>
DI void attn_tile(const LAS unsigned char* kt, const bf16x8 (&qf)[4], AttnState& st, int r, int h, MB mb) {
    f32x16 x0, x1;
    qk_tile(kt, qf, r, h, x0, x1);
    float mx = st.m;
#pragma unroll
    for (int i = 0; i < 16; ++i) { const int k0 = crow(i, h); const float a = mb(x0[i], k0), b = mb(x1[i], 32 + k0); x0[i] = a; x1[i] = b; mx = fmaxf(mx, fmaxf(a, b)); }
    mx = fmaxf(mx, __shfl_xor(mx, 32, 64));
    const float alpha = fexp2(st.m - mx); st.m = mx;
    float ls = 0.f;
#pragma unroll
    for (int i = 0; i < 16; ++i) { x0[i] = fexp2(x0[i] - mx); x1[i] = fexp2(x1[i] - mx); ls += x0[i] + x1[i]; }
    st.l = st.l * alpha + ls;
#pragma unroll
    for (int i = 0; i < 16; ++i) { st.o0[i] *= alpha; st.o1[i] *= alpha; }
    const LAS unsigned char* vt = kt + VT_OFF;
#pragma unroll
    for (int kh = 0; kh < 2; ++kh)
#pragma unroll
        for (int s = 0; s < 2; ++s) {
            const bf16x8 pb = kh ? pack8(x1, s) : pack8(x0, s);
            const int keyoff = (32 * kh + 16 * s + 4 * h) * 2;
            { const LAS unsigned char* vp = vt + r * VT_STRIDE + keyoff; const s16x4 lo = *(const LAS s16x4*)vp, hi = *(const LAS s16x4*)(vp + 16);
              const bf16x8 pa = __builtin_shufflevector(lo, hi, 0, 1, 2, 3, 4, 5, 6, 7); st.o0 = MFMA32(pa, pb, st.o0); }
            { const LAS unsigned char* vp = vt + (32 + r) * VT_STRIDE + keyoff; const s16x4 lo = *(const LAS s16x4*)vp, hi = *(const LAS s16x4*)(vp + 16);
              const bf16x8 pa = __builtin_shufflevector(lo, hi, 0, 1, 2, 3, 4, 5, 6, 7); st.o1 = MFMA32(pa, pb, st.o1); }
        }
}

DI void cmp_unit(const Params& P, LAS unsigned char* lds, int u) {
    const int tid = threadIdx.x, w = tid >> 6, lane = tid & 63, r = lane & 31, h = lane >> 5;
    const int which = u >> 6, b = (u >> 4) & 3, g = (u >> 3) & 1, ct = u & 7;
    unsigned char* ws = P.ws;
    const bf16_t* src = (const bf16_t*)(ws + WS_PJKV) + which * 128 + g * 64;
    const float* pe = which ? P.pe_v : P.pe_k;
    const bf16_t* W1t = (const bf16_t*)(ws + (which ? WS_W1V : WS_W1K));
    const bf16_t* W2t = (const bf16_t*)(ws + (which ? WS_W2V : WS_W2K));
    bf16_t* outp = (bf16_t*)(ws + (which ? WS_VC : WS_KC));
    const int cbase = 32 * ct; int c = cbase + r; if (c > 254) c = 254;
    f32x16 acc[4];
#pragma unroll
    for (int nt = 0; nt < 4; ++nt)
#pragma unroll
        for (int i = 0; i < 16; ++i) acc[nt][i] = 0.f;
#pragma unroll 1
    for (int jj = 0; jj < 4; ++jj) {
        const int j = 4 * w + jj; const bf16_t* rowp = src + (size_t)(b * S_ + 16 * c + j) * 768;
#pragma unroll
        for (int kk = 0; kk < 4; ++kk) {
            const int d0 = 16 * kk + 8 * h;
            const u32x4 raw = *(const u32x4*)(rowp + d0);
            const f32x4 p0 = *(const f32x4*)(pe + j * 64 + d0), p1 = *(const f32x4*)(pe + j * 64 + d0 + 4);
            u32x4 av; av.x = pk2(bf2f(raw.x & 0xffffu) + p0[0], bf2f(raw.x >> 16) + p0[1]); av.y = pk2(bf2f(raw.y & 0xffffu) + p0[2], bf2f(raw.y >> 16) + p0[3]);
            av.z = pk2(bf2f(raw.z & 0xffffu) + p1[0], bf2f(raw.z >> 16) + p1[1]); av.w = pk2(bf2f(raw.w & 0xffffu) + p1[2], bf2f(raw.w >> 16) + p1[3]);
            const bf16x8 a = __builtin_bit_cast(bf16x8, av);
#pragma unroll
            for (int nt = 0; nt < 4; ++nt) { const bf16x8 bb = *(const bf16x8*)(W1t + (size_t)(32 * nt + r) * 2048 + j * 64 + d0); acc[nt] = MFMA32(a, bb, acc[nt]); }
        }
    }
    __syncthreads();
    LAS float* part = (LAS float*)lds;
#pragma unroll
    for (int nt = 0; nt < 4; ++nt)
#pragma unroll
        for (int i = 0; i < 16; ++i) part[(w * 32 + crow(i, h)) * 128 + 32 * nt + r] = acc[nt][i];
    __syncthreads();
    LAS unsigned char* hidb = lds + HIDB_OFF;
#pragma unroll
    for (int e = 0; e < 8; ++e) { const int o = tid + 512 * e; float s = 0.f;
#pragma unroll
        for (int ww = 0; ww < 8; ++ww) s += part[ww * 4096 + o];
        const float gl = gelu_tanh(s); const int cl = o >> 7, n = o & 127;
        *(LAS unsigned short*)(hidb + cl * HIDB_STRIDE + n * 2) = (unsigned short)(pk2(gl, 0.f) & 0xffffu); }
    __syncthreads();
    if (w < 2) {
        f32x16 a2;
#pragma unroll
        for (int i = 0; i < 16; ++i) a2[i] = 0.f;
#pragma unroll
        for (int ks = 0; ks < 8; ++ks) { const bf16x8 a = *(const LAS bf16x8*)(hidb + r * HIDB_STRIDE + (16 * ks + 8 * h) * 2);
            const bf16x8 bb = *(const bf16x8*)(W2t + (size_t)(32 * w + r) * 128 + 16 * ks + 8 * h); a2 = MFMA32(a, bb, a2); }
#pragma unroll
        for (int i = 0; i < 16; ++i) outp[((size_t)(b * 2 + g) * 256 + cbase + crow(i, h)) * 64 + 32 * w + r] = (bf16_t)(pk2(a2[i], 0.f) & 0xffffu);
    }
    __syncthreads();
}

DI void dil_unit(const Params& P, LAS unsigned char* lds, int b, int g, int u64) {
    const int tid = threadIdx.x, w = tid >> 6, lane = tid & 63, r = lane & 31, h = lane >> 5;
    const int hh = w >> 1, qh = w & 1;
    const int rd = (g == 0) ? 1 : (g == 1 ? 4 : 16), ntr = 64 / rd, c = u64 / ntr, ut = u64 % ntr;
    const int uq = 64 * ut + 32 * qh + r, tq = c + rd * uq; const size_t trow = (size_t)b * S_ + tq;
    const int head = g * 4 + hh;
    const float sl2 = fexp2(-(float)(head + 1) * (2.0f / 3.0f)) * LOG2E * (float)rd, sc2 = 0.125f * LOG2E;
    unsigned char* ws = P.ws;
    const bf16_t* PJB = (const bf16_t*)(ws + WS_PJB);
    bf16x8 qf[4];
#pragma unroll
    for (int kk = 0; kk < 4; ++kk) qf[kk] = *(const bf16x8*)(PJB + trow * 2304 + g * 256 + hh * 64 + 16 * kk + 8 * h);
    AttnState st; attn_init(st);
    LAS unsigned char* kt = lds + hh * KV_REGION;
    const int kt0 = ut >= 2 ? ut - 2 : 0;
#pragma unroll 1
    for (int t = kt0; t <= ut; ++t) {
        __syncthreads();
        const bf16_t* kb = PJB + ((size_t)b * S_ + c + (size_t)rd * 64 * t) * 2304 + 768 + g * 256 + hh * 64;
        stage_kv(kt, kb, kb + 768, (size_t)rd * 2304, tid & 127, 128, true);
        __syncthreads();
        const int ubase = uq - 64 * t;
        attn_tile(kt, qf, st, r, h, [=](float raw, int key) { const int du = ubase - key; return (du >= 0 && du <= 128) ? raw * sc2 - sl2 * (float)du : -1e30f; });
    }
    const float l = st.l + __shfl_xor(st.l, 32, 64), inv = 1.0f / l;
    bf16_t* od = (bf16_t*)(ws + WS_OD) + ((size_t)g * T_ + trow) * 256 + hh * 64;
#pragma unroll
    for (int gq = 0; gq < 4; ++gq) {
        u32x2 w0; w0.x = pk2(st.o0[4 * gq] * inv, st.o0[4 * gq + 1] * inv); w0.y = pk2(st.o0[4 * gq + 2] * inv, st.o0[4 * gq + 3] * inv);
        *(u32x2*)(od + 8 * gq + 4 * h) = w0;
        u32x2 w1; w1.x = pk2(st.o1[4 * gq] * inv, st.o1[4 * gq + 1] * inv); w1.y = pk2(st.o1[4 * gq + 2] * inv, st.o1[4 * gq + 3] * inv);
        *(u32x2*)(od + 32 + 8 * gq + 4 * h) = w1;
    }
    if (h == 0) ((float*)(ws + WS_LSE))[((size_t)g * T_ + trow) * 4 + hh] = (st.m + __log2f(l)) * LN2;
}

DI void nsa_unit(const Params& P, LAS unsigned char* lds, int b, int g, int i) {
    const int tid = threadIdx.x, w = tid >> 6, lane = tid & 63, r = lane & 31, h = lane >> 5;
    const int rr = w >> 1, qh = w & 1, head = g * 4 + rr;
    const int ql = 32 * qh + r, tq = 64 * i + ql; const size_t trow = (size_t)b * S_ + tq;
    const float sl2 = fexp2(-(float)(head + 1)) * LOG2E, sc2 = 0.125f * LOG2E;
    unsigned char* ws = P.ws;
    const bf16_t* PJQ = (const bf16_t*)(ws + WS_PJQ); const bf16_t* PJKV = (const bf16_t*)(ws + WS_PJKV); const bf16_t* PJG = (const bf16_t*)(ws + WS_PJG);
    bf16x8 qf[4];
#pragma unroll
    for (int kk = 0; kk < 4; ++kk) qf[kk] = *(const bf16x8*)(PJQ + trow * 512 + head * 64 + 16 * kk + 8 * h);
    const float g0 = sigmoidf_(bf2f(PJG[trow * 256 + head * 3 + 0])), g1 = sigmoidf_(bf2f(PJG[trow * 256 + head * 3 + 1])), g2 = sigmoidf_(bf2f(PJG[trow * 256 + head * 3 + 2]));
    LAS unsigned char* kt = lds;
    f32x16 oa0, oa1;
    const int ncmp = 4 * i + 3, ntc = (ncmp + 63) >> 6;
    const bf16_t* KC = (const bf16_t*)(ws + WS_KC) + (size_t)(b * 2 + g) * 256 * 64;
    const bf16_t* VC = (const bf16_t*)(ws + WS_VC) + (size_t)(b * 2 + g) * 256 * 64;
    AttnState st; attn_init(st);
#pragma unroll 1
    for (int t = 0; t < ntc; ++t) {
        __syncthreads();
        stage_kv(kt, KC + (size_t)t * 64 * 64, VC + (size_t)t * 64 * 64, 64, tid, 512, true);
        __syncthreads();
        const int dbase = tq - 31 - 1024 * t;
        attn_tile(kt, qf, st, r, h, [=](float raw, int key) { const int d = dbase - 16 * key; return (d >= 0) ? raw * sc2 - sl2 * (float)d : -1e30f; });
    }
    const float mc = st.m; float lc = st.l + __shfl_xor(st.l, 32, 64); const float invc = lc > 0.f ? 1.0f / lc : 0.f;
    { const float sgc = g0 * invc;
#pragma unroll
      for (int e = 0; e < 16; ++e) { oa0[e] = st.o0[e] * sgc; oa1[e] = st.o1[e] * sgc; } }
    {
        LAS float* imp = (LAS float*)(lds + IMP_OFF) + (rr * 64 + ql) * IMP_QS;
        float carry = 0.f;
#pragma unroll 1
        for (int t = 0; t < ntc; ++t) {
            __syncthreads();
            stage_kv(kt, KC + (size_t)t * 64 * 64, VC, 64, tid, 512, false);
            __syncthreads();
            f32x16 x0, x1; qk_tile(kt, qf, r, h, x0, x1);
            const int dbase = tq - 31 - 1024 * t;
#pragma unroll
            for (int kh = 0; kh < 2; ++kh) {
                float mainv[4], sp[4], recv[4];
#pragma unroll
                for (int gq = 0; gq < 4; ++gq) {
                    float p[4];
#pragma unroll
                    for (int e = 0; e < 4; ++e) { const int key = 32 * kh + 8 * gq + 4 * h + e; const int d = dbase - 16 * key;
                        const float raw = kh ? x1[4 * gq + e] : x0[4 * gq + e];
                        p[e] = (d >= 0) ? fexp2(raw * sc2 - sl2 * (float)d - mc) * invc : 0.f; }
                    mainv[gq] = (p[0] + p[1]) + (p[2] + 0.5f * p[3]); sp[gq] = 0.5f * p[3];
                }
#pragma unroll
                for (int gq = 0; gq < 4; ++gq) recv[gq] = __shfl_xor(sp[gq], 32, 64);
#pragma unroll
                for (int gq = 0; gq < 4; ++gq) { const float add = h ? recv[gq] : (gq ? recv[gq > 0 ? gq - 1 : 0] : carry);
                    imp[16 * t + 8 * kh + 2 * gq + h] = mainv[gq] + add; }
                carry = recv[3];
            }
        }
    }
    __syncthreads();
    {
        LAS unsigned long long* selm = (LAS unsigned long long*)(lds + SEL_OFF);
        LAS unsigned long long* uni = (LAS unsigned long long*)(lds + UNI_OFF);
        unsigned long long un = 0ull;
        if (i <= 15) { const unsigned long long m = (2ull << i) - 1ull; if (lane < 8) selm[8 * w + lane] = m; un = m; }
        else {
            const LAS float* impb = (const LAS float*)(lds + IMP_OFF);
#pragma unroll 1
            for (int qq = 0; qq < 8; ++qq) { const int q = 8 * w + qq;
                const float v = (impb[(0 * 64 + q) * IMP_QS + lane] + impb[(1 * 64 + q) * IMP_QS + lane]) + (impb[(2 * 64 + q) * IMP_QS + lane] + impb[(3 * 64 + q) * IMP_QS + lane]);
                const bool cand = (lane >= 1) && (lane <= i - 1);
                const float key = cand ? v : -2.0f; const int keyi = __float_as_int(key);
                int rank = 0;
#pragma unroll 8
                for (int s2 = 0; s2 < 64; ++s2) { const float o = __int_as_float(__builtin_amdgcn_readlane(keyi, s2)); rank += ((o > key) || (o == key && s2 < lane)) ? 1 : 0; }
                const bool sel = (lane == 0) || (lane == i) || (cand && rank < 14);
                const unsigned long long m = __ballot(sel);
                if (lane == 0) selm[q] = m;
                un |= m; }
        }
        if (lane == 0) uni[w] = un;
    }
    __syncthreads();
    unsigned long long myq, un;
    { const LAS unsigned long long* selm = (const LAS unsigned long long*)(lds + SEL_OFF); const LAS unsigned long long* uni = (const LAS unsigned long long*)(lds + UNI_OFF);
      myq = selm[ql]; un = ((uni[0] | uni[1]) | (uni[2] | uni[3])) | ((uni[4] | uni[5]) | (uni[6] | uni[7])); }
    attn_init(st);
#pragma unroll 1
    for (int s = 0; s <= i; ++s) {
        if (!((un >> s) & 1ull)) continue;
        __syncthreads();
        const bf16_t* kb = PJKV + ((size_t)b * S_ + 64 * s) * 768 + 2 * 128 + g * 64;
        stage_kv(kt, kb, kb + 128, 768, tid, 512, true);
        __syncthreads();
        const bool selq = (myq >> s) & 1ull; const int dbase = tq - 64 * s;
        attn_tile(kt, qf, st, r, h, [=](float raw, int key) { const int d = dbase - key; return (selq && d >= 0) ? raw * sc2 - sl2 * (float)d : -1e30f; });
    }
    { const float l = st.l + __shfl_xor(st.l, 32, 64); const float sg = l > 0.f ? g1 / l : 0.f;
#pragma unroll
      for (int e = 0; e < 16; ++e) { oa0[e] += st.o0[e] * sg; oa1[e] += st.o1[e] * sg; } }
    attn_init(st);
#pragma unroll 1
    for (int s = (i >= 8 ? i - 8 : 0); s <= i; ++s) {
        __syncthreads();
        const bf16_t* kb = PJKV + ((size_t)b * S_ + 64 * s) * 768 + 4 * 128 + g * 64;
        stage_kv(kt, kb, kb + 128, 768, tid, 512, true);
        __syncthreads();
        const int dbase = tq - 64 * s;
        attn_tile(kt, qf, st, r, h, [=](float raw, int key) { const int d = dbase - key; return (d >= 0 && d < 512) ? raw * sc2 - sl2 * (float)d : -1e30f; });
    }
    { const float l = st.l + __shfl_xor(st.l, 32, 64); const float sg = l > 0.f ? g2 / l : 0.f;
#pragma unroll
      for (int e = 0; e < 16; ++e) { oa0[e] += st.o0[e] * sg; oa1[e] += st.o1[e] * sg; } }
    bf16_t* oab = (bf16_t*)P.out + trow * 768 + head * 64;
#pragma unroll
    for (int gq = 0; gq < 4; ++gq) {
        u32x2 w0; w0.x = pk2(oa0[4 * gq], oa0[4 * gq + 1]); w0.y = pk2(oa0[4 * gq + 2], oa0[4 * gq + 3]); *(u32x2*)(oab + 8 * gq + 4 * h) = w0;
        u32x2 w1; w1.x = pk2(oa1[4 * gq], oa1[4 * gq + 1]); w1.y = pk2(oa1[4 * gq + 2], oa1[4 * gq + 3]); *(u32x2*)(oab + 32 + 8 * gq + 4 * h) = w1;
    }
    __syncthreads();
}

__device__ __attribute__((noinline)) void grid_sync_call() { cg::this_grid().sync(); }
__global__ void __launch_bounds__(512, 2) fwd_megakernel(Params P) {
    extern __shared__ __attribute__((aligned(16))) unsigned char lds_raw[];
    LAS unsigned char* lds = (LAS unsigned char*)lds_raw;
    const int tid = threadIdx.x, G = gridDim.x, bid = blockIdx.x;
    unsigned char* ws = P.ws;
    const int lo = P.ph_lo, hi = P.ph_hi;
#define IN(k) (lo <= (k) && (k) < hi)
#define SEAM(k) do { if (IN(k) && IN((k) + 1)) grid_sync_call(); } while (0)

    if (IN(0)) { p0_prologue(P, lds); __syncthreads(); }
    SEAM(0);
    if (IN(1)) {
        pg8::Gemm g{(const bf16_t*)(ws + WS_H1), (const bf16_t*)(ws + WS_WIN), T_, NIN, 1024, 1024, 128}; pg8::StaticOrder S; S.init(T_, NIN, G, bid);
        pg8::EpiProj E{ws}; pg8::gemm_phase(lds, g, S, E);
    }
    SEAM(1);
    if (IN(2)) {
        for (int u = bid; u < 128 + 768; u += G) {
            if (u < 128) cmp_unit(P, lds, u);
            else { const int v = u - 128; dil_unit(P, lds, v / 192, (v / 64) % 3, v % 64); }
        }
        __syncthreads();
    }
    SEAM(2);
    if (IN(3)) {
        for (int p = bid; p < 256; p += G) { const int b = p >> 6, g = (p >> 5) & 1, ip = p & 31;
            nsa_unit(P, lds, b, g, 63 - ip); nsa_unit(P, lds, b, g, ip); }
        const bf16_t* OD = (const bf16_t*)(ws + WS_OD); const float* LSE = (const float*)(ws + WS_LSE); bf16_t* oab = (bf16_t*)P.out;
        for (int it = bid * 512 + tid; it < T_ * 32; it += G * 512) { const int t = it >> 5, hh = (it >> 3) & 3, dc = it & 7;
            const float l0 = LSE[(size_t)t * 4 + hh], l1 = LSE[((size_t)T_ + t) * 4 + hh], l2 = LSE[((size_t)2 * T_ + t) * 4 + hh];
            const float mx = fmaxf(l0, fmaxf(l1, l2)); const float e0 = __expf(l0 - mx), e1 = __expf(l1 - mx), e2 = __expf(l2 - mx); const float inv = 1.0f / (e0 + e1 + e2);
            f32x4 a0, a1, b0, b1, c0, c1; pg8::load8(OD + (size_t)t * 256 + hh * 64 + dc * 8, a0, a1); pg8::load8(OD + ((size_t)T_ + t) * 256 + hh * 64 + dc * 8, b0, b1);
            pg8::load8(OD + ((size_t)2 * T_ + t) * 256 + hh * 64 + dc * 8, c0, c1);
            const float w0 = e0 * inv, w1 = e1 * inv, w2 = e2 * inv;
            pg8::store8(oab + (size_t)t * 768 + 512 + hh * 64 + dc * 8, a0 * w0 + b0 * w1 + c0 * w2, a1 * w0 + b1 * w1 + c1 * w2); }
    }
    SEAM(3);
    if (IN(4)) {
        { pg8::Gemm g{(const bf16_t*)P.out, (const bf16_t*)(ws + WS_WPN), T_, 1024, 512, 768, 128}; pg8::StaticOrder S; S.init(T_, 1024, G, bid);
          pg8::EpiMerge<0> E{(const bf16_t*)(ws + WS_PJM), (bf16_t*)(ws + WS_MIX)}; pg8::gemm_phase(lds, g, S, E); }
        { pg8::Gemm g{(const bf16_t*)P.out + 512, (const bf16_t*)(ws + WS_WPD), T_, 1024, 256, 768, 128}; pg8::StaticOrder S; S.init(T_, 1024, G, bid);
          pg8::EpiMerge<1> E{(const bf16_t*)(ws + WS_PJM), (bf16_t*)(ws + WS_MIX)}; pg8::gemm_phase(lds, g, S, E); }
    }
    SEAM(4);
    if (IN(5)) {
        pg8::Gemm g{(const bf16_t*)(ws + WS_MIX), (const bf16_t*)(ws + WS_WOUT), T_, 1024, 1024, 1024, 128}; pg8::StaticOrder S; S.init(T_, 1024, G, bid);
        pg8::EpiResid<1> E{P.x, P.out, (bf16_t*)(ws + WS_A2), P.g_ffn, (float*)(ws + WS_SSQ2)}; pg8::gemm_phase(lds, g, S, E);
    }
    SEAM(5);
    if (IN(6)) {
        pg8::Gemm g{(const bf16_t*)(ws + WS_A2), (const bf16_t*)(ws + WS_WUP), T_, NUP, 1024, 1024, 128}; pg8::StaticOrder S; S.init(T_, NUP, G, bid);
        pg8::EpiUp E{(const float*)(ws + WS_SSQ2), (bf16_t*)(ws + WS_UG)}; pg8::gemm_phase(lds, g, S, E);
    }
    SEAM(6);
    if (IN(7)) {
        bf16_t* UG = (bf16_t*)(ws + WS_UG);
        for (int it = bid * 512 + tid; it < (T_ / 8) * 352; it += G * 512) { const int cc = it % 352, tb = it / 352, c0 = cc * 8, t0 = tb * 8;
            const size_t colu = (size_t)(c0 >> 7) * 256 + (c0 & 127);
            const f32x4 wa0 = *(const f32x4*)(P.conv_w + c0), wa1 = *(const f32x4*)(P.conv_w + c0 + 4), wb0 = *(const f32x4*)(P.conv_w + DFF + c0), wb1 = *(const f32x4*)(P.conv_w + DFF + c0 + 4);
            const f32x4 wc0 = *(const f32x4*)(P.conv_w + 2 * DFF + c0), wc1 = *(const f32x4*)(P.conv_w + 2 * DFF + c0 + 4), cb0 = *(const f32x4*)(P.conv_b + c0), cb1 = *(const f32x4*)(P.conv_b + c0 + 4);
            f32x4 um2a = {0.f, 0.f, 0.f, 0.f}, um2b = um2a, um1a = um2a, um1b = um2a;
            if ((t0 & (S_ - 1)) != 0) { pg8::load8(UG + (size_t)(t0 - 2) * NUP + colu, um2a, um2b); pg8::load8(UG + (size_t)(t0 - 1) * NUP + colu, um1a, um1b); }
#pragma unroll 1
            for (int k = 0; k < 8; ++k) { const size_t rowo = (size_t)(t0 + k) * NUP + colu;
                f32x4 ua, ub, ga, gb; pg8::load8(UG + rowo, ua, ub); pg8::load8(UG + rowo + 128, ga, gb);
                f32x4 va = cb0 + wa0 * um2a + wb0 * um1a + wc0 * ua, vb = cb1 + wa1 * um2b + wb1 * um1b + wc1 * ub;
#pragma unroll
                for (int e = 0; e < 4; ++e) { va[e] = gelu_tanh(va[e]) * ga[e]; vb[e] = gelu_tanh(vb[e]) * gb[e]; }
                pg8::store8(UG + rowo + 128, va, vb);
                um2a = um1a; um2b = um1b; um1a = ua; um1b = ub; }
        }
    }
    SEAM(7);
    if (IN(8)) {
        pg8::Gemm g{(const bf16_t*)(ws + WS_UG) + 128, (const bf16_t*)(ws + WS_WDN), T_, 1024, DFF, NUP, 256}; pg8::StaticOrder S; S.init(T_, 1024, G, bid);
        pg8::EpiResid<0> E{P.out, P.out, nullptr, nullptr, (float*)(ws + WS_SSQ3)}; pg8::gemm_phase(lds, g, S, E);
    }
    SEAM(8);
    if (IN(9)) {
        const int lane = tid & 63, gw = bid * 8 + (tid >> 6), NGW = G * 8; const float* ssq = (const float*)(ws + WS_SSQ3);
        f32x4 gv[4];
#pragma unroll
        for (int j = 0; j < 4; ++j) gv[j] = ((const f32x4*)P.g_final)[lane + 64 * j];
        for (int m = gw; m < T_; m += NGW) {
            const f32x4* sp = (const f32x4*)(ssq + (size_t)m * 16); const f32x4 st = (sp[0] + sp[1]) + (sp[2] + sp[3]);
            const float rstd = 1.0f / sqrtf(((st[0] + st[1]) + (st[2] + st[3])) * (1.0f / 1024.0f) + RMS_EPS);
            f32x4* xr = (f32x4*)(P.out + (size_t)m * D_) + lane;
#pragma unroll
            for (int j = 0; j < 4; ++j) xr[64 * j] = xr[64 * j] * rstd * gv[j];
        }
    }
#undef IN
#undef SEAM
}

extern "C" void kernel_launch(void* const* d_in, const int* in_sizes, int n_in, void* d_out, int out_size, void* d_ws, size_t ws_size, hipStream_t stream) {
    static int grid = 0;
    if (grid == 0) {
        if (n_in != 18 || ws_size < WS_END) { fprintf(stderr, "kernel_launch: unexpected inputs (n_in %d, ws %zu)\n", n_in, ws_size); grid = -1; return; }
        int dev = 0, cus = 0, per_cu = 0;
        (void)hipGetDevice(&dev); (void)hipDeviceGetAttribute(&cus, hipDeviceAttributeMultiprocessorCount, dev);
        if (hipFuncSetAttribute((const void*)fwd_megakernel, hipFuncAttributeMaxDynamicSharedMemorySize, LDS_BYTES) != hipSuccess) { fprintf(stderr, "hipFuncSetAttribute failed\n"); grid = -1; return; }
        if (hipOccupancyMaxActiveBlocksPerMultiprocessor(&per_cu, (const void*)fwd_megakernel, 512, LDS_BYTES) != hipSuccess || per_cu < 1) per_cu = 1;
        (void)hipGetLastError();
        grid = cus * per_cu;
    }
    if (grid < 0) return;
    Params p{};
    const float** f = (const float**)&p;
    for (int i = 0; i < 18; ++i) f[i] = (const float*)d_in[i];
    p.out = (float*)d_out; p.ws = (unsigned char*)d_ws; p.ph_lo = 0; p.ph_hi = 10;
    void* args[] = {&p};
    hipError_t e = hipLaunchCooperativeKernel((const void*)fwd_megakernel, dim3(grid), dim3(512), args, LDS_BYTES, stream);
    if (e != hipSuccess) fprintf(stderr, "cooperative launch failed: %s (grid %d)\n", hipGetErrorString(e), grid);
}
```

```cpp
#include <hip/hip_runtime.h>
#include <hip/hip_cooperative_groups.h>
#include <cstdio>
#include <cstdint>
namespace cg = cooperative_groups;

#define LAS __attribute__((address_space(3)))
#define DI __device__ __forceinline__
typedef unsigned short bf16_t;
typedef short bf16x8 __attribute__((ext_vector_type(8)));
typedef short s16x4 __attribute__((ext_vector_type(4)));
typedef float f32x4 __attribute__((ext_vector_type(4)));
typedef float f32x2 __attribute__((ext_vector_type(2)));
typedef float f32x16 __attribute__((ext_vector_type(16)));
typedef unsigned u32x4 __attribute__((ext_vector_type(4)));
typedef unsigned u32x2 __attribute__((ext_vector_type(2)));
typedef __bf16 bf16x2v __attribute__((ext_vector_type(2)));

constexpr int B_ = 4, S_ = 4096, D_ = 1024, T_ = B_ * S_;
constexpr int NIN = 5888;
constexpr int NINSRC = 5656;
constexpr int DFF = 2816, NUP = 5632;
constexpr float RMS_EPS = 1e-6f;
constexpr float LOG2E = 1.4426950408889634f, LN2 = 0.6931471805599453f;

constexpr size_t MiB = 1u << 20;
constexpr size_t WS_WIN = 0;
constexpr size_t WS_WUP = WS_WIN + (size_t)NIN * 1024 * 2;
constexpr size_t WS_WDN = WS_WUP + (size_t)NUP * 1024 * 2;
constexpr size_t WS_WOUT = WS_WDN + (size_t)1024 * DFF * 2;
constexpr size_t WS_WPN = WS_WOUT + (size_t)1024 * 1024 * 2;
constexpr size_t WS_WPD = WS_WPN + (size_t)1024 * 512 * 2;
constexpr size_t WS_W1K = WS_WPD + (size_t)1024 * 256 * 2;
constexpr size_t WS_W1V = WS_W1K + (size_t)128 * 2048 * 2;
constexpr size_t WS_W2K = WS_W1V + (size_t)128 * 2048 * 2;
constexpr size_t WS_W2V = WS_W2K + (size_t)64 * 128 * 2;
constexpr size_t WS_WEND = WS_W2V + (size_t)64 * 128 * 2;
constexpr size_t WS_R1 = 33 * MiB;
constexpr size_t WS_PJQ = WS_R1, WS_PJKV = WS_R1 + 16 * MiB, WS_PJB = WS_R1 + 40 * MiB, WS_PJM = WS_R1 + 112 * MiB, WS_PJG = WS_R1 + 176 * MiB;
constexpr size_t WS_MIX = WS_R1;
constexpr size_t WS_UG = WS_R1;
constexpr size_t WS_R2 = 217 * MiB;
constexpr size_t WS_H1 = WS_R2, WS_OD = WS_R2, WS_LSE = WS_R2 + 24 * MiB, WS_A2 = WS_R2;
constexpr size_t WS_KC = 249 * MiB, WS_VC = WS_KC + 262144, WS_SSQ2 = 250 * MiB, WS_SSQ3 = 251 * MiB, WS_CTL = 252 * MiB, CTL_BYTES = 16384, WS_END = 253 * MiB;
static_assert(WS_WEND <= WS_R1, "weights");

constexpr int LDS_BYTES = 147456;
constexpr int KT_STRIDE = 144, VT_STRIDE = 136, VT_OFF = 64 * KT_STRIDE, KV_REGION = VT_OFF + 64 * VT_STRIDE;
constexpr int IMP_OFF = 73728, IMP_QS = 65, IMP_BYTES = 4 * 64 * IMP_QS * 4;
constexpr int SEL_OFF = IMP_OFF + IMP_BYTES, UNI_OFF = SEL_OFF + 512;
static_assert(UNI_OFF + 64 <= LDS_BYTES, "lds");
constexpr int HIDB_OFF = 131072, HIDB_STRIDE = 272;
constexpr int ST_OFF = LDS_BYTES - 16;

struct Params {
    const float *x, *g_mix, *w_in, *pe_k, *w_k1, *w_k2, *pe_v, *w_v1, *w_v2, *w_pn, *w_pd, *w_out, *g_ffn, *w_up, *conv_w, *conv_b, *w_down, *g_final;
    float* out; unsigned char* ws; int ph_lo, ph_hi;
};

DI float bf2f(unsigned v) { return __builtin_bit_cast(float, v << 16); }
DI unsigned pk2(float a, float b) { f32x2 v = {a, b}; return __builtin_bit_cast(unsigned, __builtin_convertvector(v, bf16x2v)); }
DI float wave_sum(float v) {
#pragma unroll
    for (int o = 1; o < 64; o <<= 1) v += __shfl_xor(v, o, 64);
    return v;
}
DI float fexp2(float x) { return __builtin_amdgcn_exp2f(x); }
DI float sigmoidf_(float x) { return 1.0f / (1.0f + __expf(-x)); }
DI float gelu_tanh(float x) {
    const float y = 0.7978845608028654f * (x + 0.044715f * x * x * x);
    const float e = __expf(2.0f * y);
    const float t = 1.0f - 2.0f / (e + 1.0f);
    return 0.5f * x * (1.0f + t);
}
DI int crow(int i, int h) { return (i & 3) + 8 * (i >> 2) + 4 * h; }
#define MFMA32(a, b, c) __builtin_amdgcn_mfma_f32_32x32x16_bf16((a), (b), (c), 0, 0, 0)

namespace pg8 {
constexpr int BM = 256, BK = 64, HALF = 128, HTB = HALF * BK * 2, NXCD = 8, WGM = 8;
DI int lds_byte(int r, int c) { const int st = (r >> 4) * 2 + (c >> 5), rr = r & 15, cc = c & 31, ob = rr * 64 + cc * 2; return st * 1024 + (ob ^ (((ob >> 9) & 1) << 5)); }
DI void stage_rc(int b, int& R, int& C) { const int st = b / 1024, sb = b % 1024, swz = sb ^ (((sb >> 9) & 1) << 5); R = (st >> 1) * 16 + swz / 64; C = (st & 1) * 32 + (swz % 64) / 2; }
DI int perm32(int rho) { const int n = rho >> 4, i = rho & 15; return 8 * (i >> 2) + 4 * n + (i & 3); }
struct Unit { int pm, pn; };
struct Gemm { const bf16_t* A; const bf16_t* Bt; int M, N, K, lda, apair; };
struct StaticOrder {
    int nM, nN, nwg, G, c;
    DI void init(int M, int N, int G_, int c_) { nM = M / BM; nN = N / BM; nwg = nM * nN; G = G_; c = c_; }
    DI bool next(int i, Unit& u) const {
        const long L = (long)i * G + c; if (L >= nwg) return false;
        int wgid = (int)L; { const int q = nwg / NXCD, r = nwg % NXCD, xcd = wgid % NXCD, off = wgid / NXCD; wgid = (xcd < r ? xcd * (q + 1) : r * (q + 1) + (xcd - r) * q) + off; }
        const int nig = WGM * nN, gid = wgid / nig, fm = gid * WGM, gsz = (nM - fm) < WGM ? (nM - fm) : WGM;
        u.pm = fm + ((wgid % nig) % gsz); u.pn = (wgid % nig) / gsz; return true;
    }
};
template <class Epi>
DI void gemm_phase(LAS unsigned char* lds, const Gemm g, const StaticOrder& S, const Epi& E) {
    const int tid = threadIdx.x, wid = __builtin_amdgcn_readfirstlane(tid >> 6), lane = tid & 63, wr = wid >> 2, wc = wid & 3, fr = lane & 15, fq = lane >> 4;
    const int K = g.K, nt = K / BK, lda = g.lda;
    unsigned voffA[2], voffB[2];
#pragma unroll
    for (int i = 0; i < 2; ++i) { int R, C; stage_rc(tid * 16 + i * 8192, R, C); const int Rb = (R & ~31) + perm32(R & 31);
        voffA[i] = (unsigned)(R * lda + C) * 2u; voffB[i] = (unsigned)(Rb * K + C) * 2u; }
    const size_t kstep = (size_t)(BK * 2);
    const size_t apairB = (size_t)g.apair * 2;
    const size_t hstepA = (size_t)HALF * lda * 2, tstepA = 2 * hstepA;
    const size_t hstepB = (size_t)HALF * K * 2, tstepB = 2 * hstepB;
    const unsigned ldsw = (unsigned)wid * 1024u;
    const int aoff = lds_byte(wr * 64 + fr, fq * 8), boff = lds_byte(wc * 32 + fr, fq * 8);
#define PG8_SA(b, h) (((b) * 2 + (h)) * HTB)
#define PG8_SB(b, h) ((4 + (b) * 2 + (h)) * HTB)
#define PG8_STAGE(bufoff, gbase, voff) do { _Pragma("unroll") for (int _i = 0; _i < 2; ++_i) \
        __builtin_amdgcn_global_load_lds((const unsigned*)((const char*)(gbase) + (voff)[_i]), (LAS unsigned*)(lds + (bufoff) + ldsw + _i * 8192), 16, 0, 0); } while (0)
#define PG8_LDA(dst, b, h) do { _Pragma("unroll") for (int m = 0; m < 4; ++m) _Pragma("unroll") for (int k = 0; k < 2; ++k) dst[m][k] = *(const LAS bf16x8*)(lds + PG8_SA(b, h) + aoff + m * 2048 + k * 1024); } while (0)
#define PG8_LDB(dst, b, h) do { _Pragma("unroll") for (int n = 0; n < 2; ++n) _Pragma("unroll") for (int k = 0; k < 2; ++k) dst[n][k] = *(const LAS bf16x8*)(lds + PG8_SB(b, h) + boff + n * 2048 + k * 1024); } while (0)
#define PG8_MMA(ai, bj, At, Bt) do { __builtin_amdgcn_s_setprio(1); _Pragma("unroll") for (int m = 0; m < 4; ++m) _Pragma("unroll") for (int n = 0; n < 2; ++n) _Pragma("unroll") for (int k = 0; k < 2; ++k) \
        acc[ai][bj][m][n] = __builtin_amdgcn_mfma_f32_16x16x32_bf16(Bt[n][k], At[m][k], acc[ai][bj][m][n], 0, 0, 0); __builtin_amdgcn_s_setprio(0); } while (0)
#define PG8_WAIT_V(n) asm volatile("s_waitcnt vmcnt(" #n ")" ::: "memory")
#define PG8_WAIT_L(n) asm volatile("s_waitcnt lgkmcnt(" #n ")" ::: "memory")
#define PG8_BAR __builtin_amdgcn_s_barrier()
#define PG8_SCHED __builtin_amdgcn_sched_barrier(0)
    Unit cur, nxt; int ui = 0;
    if (!S.next(0, cur)) return;
    f32x4 acc[2][2][4][2];
#pragma unroll
    for (int a = 0; a < 2; ++a)
#pragma unroll
        for (int b = 0; b < 2; ++b)
#pragma unroll
            for (int m = 0; m < 4; ++m)
#pragma unroll
                for (int n = 0; n < 2; ++n) acc[a][b][m][n] = (f32x4){0.f, 0.f, 0.f, 0.f};
    bf16x8 At[4][2], B0[2][2], B1[2][2];
    const char* cA = (const char*)g.A + (size_t)cur.pm * tstepA; const char* cB = (const char*)g.Bt + (size_t)cur.pn * tstepB;
    PG8_STAGE(PG8_SB(0, 0), cB, voffB); PG8_STAGE(PG8_SB(0, 1), cB + hstepB, voffB); PG8_STAGE(PG8_SA(0, 0), cA, voffA); PG8_STAGE(PG8_SA(0, 1), cA + hstepA, voffA);
    if (wr == 1) PG8_BAR;
    PG8_WAIT_V(2); PG8_BAR;
    PG8_STAGE(PG8_SB(1, 0), cB + kstep, voffB); PG8_STAGE(PG8_SA(1, 0), cA + kstep, voffA); PG8_STAGE(PG8_SB(1, 1), cB + hstepB + kstep, voffB);
    PG8_WAIT_V(6); PG8_BAR;
    for (;;) {
        const bool has_next = S.next(ui + 1, nxt);
        const char* nA = has_next ? (const char*)g.A + (size_t)nxt.pm * tstepA : cA; const char* nB = has_next ? (const char*)g.Bt + (size_t)nxt.pn * tstepB : cB;
        for (int t = 0; t < nt; t += 2) {
            const bool last = (t == nt - 2);
            const char* a1 = cA + (size_t)(t >> 1) * apairB + kstep;
            const char* a2 = last ? nA : cA + (size_t)((t >> 1) + 1) * apairB; const char* b2 = last ? nB : cB + (size_t)(t + 2) * kstep;
            const char* a3 = a2 + kstep; const char* b3 = b2 + kstep;
            PG8_LDB(B0, 0, 0); PG8_LDB(B1, 0, 1); PG8_SCHED; PG8_LDA(At, 0, 0); PG8_STAGE(PG8_SA(1, 1), a1 + hstepA, voffA);
            PG8_WAIT_V(8); PG8_WAIT_L(0); PG8_BAR; PG8_MMA(0, 0, At, B0); PG8_MMA(0, 1, At, B1); PG8_BAR; PG8_SCHED;
            PG8_LDA(At, 0, 1); PG8_STAGE(PG8_SB(0, 0), b2, voffB); PG8_STAGE(PG8_SB(0, 1), b2 + hstepB, voffB); PG8_STAGE(PG8_SA(0, 0), a2, voffA);
            PG8_WAIT_V(8); PG8_WAIT_L(0); PG8_BAR; PG8_MMA(1, 0, At, B0); PG8_MMA(1, 1, At, B1); PG8_BAR; PG8_SCHED;
            PG8_LDB(B0, 1, 0); PG8_LDB(B1, 1, 1); PG8_SCHED; PG8_LDA(At, 1, 0); PG8_STAGE(PG8_SA(0, 1), a2 + hstepA, voffA);
            PG8_WAIT_V(8); PG8_WAIT_L(0); PG8_BAR; PG8_MMA(0, 0, At, B0); PG8_MMA(0, 1, At, B1); PG8_BAR; PG8_SCHED;
            PG8_LDA(At, 1, 1); PG8_STAGE(PG8_SB(1, 0), b3, voffB); PG8_STAGE(PG8_SB(1, 1), b3 + hstepB, voffB); PG8_STAGE(PG8_SA(1, 0), a3, voffA);
            PG8_WAIT_V(8); PG8_WAIT_L(0); PG8_BAR; PG8_MMA(1, 0, At, B0); PG8_MMA(1, 1, At, B1); PG8_BAR; PG8_SCHED;
        }
        if (wr == 0) PG8_BAR;
        E(acc, cur, wr, wc, fr, fq);
        if (!has_next) break;
#pragma unroll
        for (int a = 0; a < 2; ++a)
#pragma unroll
            for (int b = 0; b < 2; ++b)
#pragma unroll
                for (int m = 0; m < 4; ++m)
#pragma unroll
                    for (int n = 0; n < 2; ++n) acc[a][b][m][n] = (f32x4){0.f, 0.f, 0.f, 0.f};
        cur = nxt; cA = nA; cB = nB; ++ui;
        if (wr == 1) PG8_BAR;
    }
    PG8_WAIT_V(0);
    PG8_BAR;
#undef PG8_SA
#undef PG8_SB
#undef PG8_STAGE
#undef PG8_LDA
#undef PG8_LDB
#undef PG8_MMA
#undef PG8_WAIT_V
#undef PG8_WAIT_L
#undef PG8_BAR
#undef PG8_SCHED
}
typedef f32x4 Acc[2][2][4][2];
DI void store8(bf16_t* p, f32x4 v0, f32x4 v1) { u32x4 w; w.x = pk2(v0[0], v0[1]); w.y = pk2(v0[2], v0[3]); w.z = pk2(v1[0], v1[1]); w.w = pk2(v1[2], v1[3]); *(u32x4*)p = w; }
DI void load8(const bf16_t* p, f32x4& v0, f32x4& v1) { const u32x4 w = *(const u32x4*)p;
    v0 = (f32x4){bf2f(w.x & 0xffffu), bf2f(w.x >> 16), bf2f(w.y & 0xffffu), bf2f(w.y >> 16)}; v1 = (f32x4){bf2f(w.z & 0xffffu), bf2f(w.z >> 16), bf2f(w.w & 0xffffu), bf2f(w.w >> 16)}; }

struct EpiProj {
    unsigned char* ws;
    DI void operator()(const Acc& acc, const Unit& u, int wr, int wc, int fr, int fq) const {
        const int pn = u.pn; bf16_t* base; int ld, ct;
        if (pn < 2) { base = (bf16_t*)(ws + WS_PJQ); ld = 512; ct = pn; }
        else if (pn < 5) { base = (bf16_t*)(ws + WS_PJKV); ld = 768; ct = pn - 2; }
        else if (pn < 14) { base = (bf16_t*)(ws + WS_PJB); ld = 2304; ct = pn - 5; }
        else if (pn < 22) { base = (bf16_t*)(ws + WS_PJM); ld = 2048; ct = pn - 14; }
        else { base = (bf16_t*)(ws + WS_PJG); ld = 256; ct = 0; }
        const int row0 = u.pm * BM + wr * 64 + fr, col0 = ct * 256 + wc * 32 + 8 * fq;
#pragma unroll
        for (int ai = 0; ai < 2; ++ai)
#pragma unroll
            for (int m = 0; m < 4; ++m) { bf16_t* rowp = base + (size_t)(row0 + ai * HALF + m * 16) * ld + col0;
#pragma unroll
                for (int bj = 0; bj < 2; ++bj) store8(rowp + bj * HALF, acc[ai][bj][m][0], acc[ai][bj][m][1]); }
    }
};
template <int SECOND> struct EpiMerge {
    const bf16_t* gate; bf16_t* mix;
    DI void operator()(const Acc& acc, const Unit& u, int wr, int wc, int fr, int fq) const {
        const int row0 = u.pm * BM + wr * 64 + fr, col0 = u.pn * BM + wc * 32 + 8 * fq;
#pragma unroll
        for (int ai = 0; ai < 2; ++ai)
#pragma unroll
            for (int m = 0; m < 4; ++m) { const size_t row = (size_t)(row0 + ai * HALF + m * 16);
#pragma unroll
                for (int bj = 0; bj < 2; ++bj) { const int col = col0 + bj * HALF;
                    f32x4 g0, g1; load8(gate + row * 2048 + SECOND * 1024 + col, g0, g1);
                    f32x4 v0 = acc[ai][bj][m][0], v1 = acc[ai][bj][m][1];
#pragma unroll
                    for (int e = 0; e < 4; ++e) { v0[e] *= sigmoidf_(g0[e]); v1[e] *= sigmoidf_(g1[e]); }
                    if (SECOND) { f32x4 p0, p1; load8(mix + row * 1024 + col, p0, p1); v0 += p0; v1 += p1; }
                    store8(mix + row * 1024 + col, v0, v1); } }
    }
};
template <int WRITE_A2> struct EpiResid {
    const float* xi; float* xo; bf16_t* a2; const float* gw; float* ssq;
    DI void operator()(const Acc& acc, const Unit& u, int wr, int wc, int fr, int fq) const {
        const int row0 = u.pm * BM + wr * 64 + fr, col0 = u.pn * BM + wc * 32 + 8 * fq;
#pragma unroll
        for (int ai = 0; ai < 2; ++ai)
#pragma unroll
            for (int m = 0; m < 4; ++m) { const size_t row = (size_t)(row0 + ai * HALF + m * 16); float ss = 0.f;
#pragma unroll
                for (int bj = 0; bj < 2; ++bj) { const int col = col0 + bj * HALF;
                    const f32x4 x0 = *(const f32x4*)(xi + row * 1024 + col), x1 = *(const f32x4*)(xi + row * 1024 + col + 4);
                    const f32x4 v0 = acc[ai][bj][m][0] + x0, v1 = acc[ai][bj][m][1] + x1;
                    *(f32x4*)(xo + row * 1024 + col) = v0; *(f32x4*)(xo + row * 1024 + col + 4) = v1;
                    ss += (v0[0] * v0[0] + v0[1] * v0[1]) + (v0[2] * v0[2] + v0[3] * v0[3]) + (v1[0] * v1[0] + v1[1] * v1[1]) + (v1[2] * v1[2] + v1[3] * v1[3]);
                    if (WRITE_A2) { const f32x4 w0 = *(const f32x4*)(gw + col), w1 = *(const f32x4*)(gw + col + 4); store8(a2 + row * 1024 + col, v0 * w0, v1 * w1); } }
                ss += __shfl_xor(ss, 16, 64); ss += __shfl_xor(ss, 32, 64);
                if (fq == 0) ssq[row * 16 + u.pn * 4 + wc] = ss; }
    }
};
struct EpiUp {
    const float* ssq; bf16_t* ug;
    DI void operator()(const Acc& acc, const Unit& u, int wr, int wc, int fr, int fq) const {
        const int row0 = u.pm * BM + wr * 64 + fr, col0 = u.pn * BM + wc * 32 + 8 * fq;
#pragma unroll
        for (int ai = 0; ai < 2; ++ai)
#pragma unroll
            for (int m = 0; m < 4; ++m) { const size_t row = (size_t)(row0 + ai * HALF + m * 16);
                const f32x4* sp = (const f32x4*)(ssq + row * 16); const f32x4 s0 = sp[0], s1 = sp[1], s2 = sp[2], s3 = sp[3];
                const f32x4 st = (s0 + s1) + (s2 + s3); const float tot = (st[0] + st[1]) + (st[2] + st[3]);
                const float rstd = __builtin_amdgcn_rsqf(tot * (1.0f / 1024.0f) + RMS_EPS);
#pragma unroll
                for (int bj = 0; bj < 2; ++bj) store8(ug + row * NUP + col0 + bj * HALF, acc[ai][bj][m][0] * rstd, acc[ai][bj][m][1] * rstd); }
    }
};
}

DI int rowmap(int mode, int n) {
    if (mode == 1) { if (n < 1280) return n; if (n < 1304) return 5632 + (n - 1280); return n - 24; }
    if (mode == 2) { if (n < DFF) return (n >> 7) * 256 + (n & 127); const int q = n - DFF; return (q >> 7) * 256 + 128 + (q & 127); }
    return n;
}
DI void transpose_item(const float* W, int K, int N, bf16_t* WT, int mode, LAS float* scr, int item, int lane) {
    const int nblk = (N + 31) / 32, kb = item / nblk, nb = item % nblk, k0 = 64 * kb, n0 = 32 * nb;
    const int nl = n0 + (lane & 31);
#pragma unroll 8
    for (int i = 0; i < 32; ++i) { const int kk = 2 * i + (lane >> 5); scr[kk * 33 + (lane & 31)] = (nl < N) ? W[(size_t)(k0 + kk) * N + nl] : 0.f; }
    asm volatile("s_waitcnt lgkmcnt(0)" ::: "memory");
    const int c = lane & 7;
#pragma unroll
    for (int j = 0; j < 4; ++j) { const int n = (lane >> 3) + 8 * j; const LAS float* s = scr + (8 * c) * 33 + n;
        u32x4 o; o.x = pk2(s[0 * 33], s[1 * 33]); o.y = pk2(s[2 * 33], s[3 * 33]); o.z = pk2(s[4 * 33], s[5 * 33]); o.w = pk2(s[6 * 33], s[7 * 33]);
        if (n0 + n < N) *(u32x4*)(WT + (size_t)rowmap(mode, n0 + n) * K + k0 + 8 * c) = o; }
    asm volatile("s_waitcnt lgkmcnt(0)" ::: "memory");
}
DI void p0_prologue(const Params& P, LAS unsigned char* lds) {
    const int tid = threadIdx.x, lane = tid & 63, wave = tid >> 6;
    LAS float* scr = (LAS float*)(lds + wave * 16384);
    const int gw = blockIdx.x * 8 + wave, NGW = gridDim.x * 8;
    unsigned char* ws = P.ws;
    int base = 0;
#define DOJOB(W_, K_, N_, OFF_, MODE_) do { const int items = ((K_) / 64) * (((N_) + 31) / 32); \
        int first = gw - (base % NGW); if (first < 0) first += NGW; \
        for (int it = first; it < items; it += NGW) transpose_item((W_), (K_), (N_), (bf16_t*)(ws + (OFF_)), (MODE_), scr, it, lane); \
        base += items; } while (0)
    DOJOB(P.w_in, 1024, NINSRC, WS_WIN, 1); DOJOB(P.w_up, 1024, NUP, WS_WUP, 2); DOJOB(P.w_down, DFF, 1024, WS_WDN, 0); DOJOB(P.w_out, 1024, 1024, WS_WOUT, 0);
    DOJOB(P.w_pn, 512, 1024, WS_WPN, 0); DOJOB(P.w_pd, 256, 1024, WS_WPD, 0); DOJOB(P.w_k1, 2048, 128, WS_W1K, 0); DOJOB(P.w_v1, 2048, 128, WS_W1V, 0);
    DOJOB(P.w_k2, 128, 64, WS_W2K, 0); DOJOB(P.w_v2, 128, 64, WS_W2V, 0);
#undef DOJOB
    { u32x4* z = (u32x4*)(ws + WS_WIN + (size_t)NINSRC * 1024 * 2); const int n16 = (NIN - NINSRC) * 1024 * 2 / 16;
      for (int i = blockIdx.x * 512 + tid; i < n16; i += gridDim.x * 512) z[i] = (u32x4){0u, 0u, 0u, 0u}; }
    bf16_t* H1 = (bf16_t*)(ws + WS_H1);
    f32x4 gv[4];
#pragma unroll
    for (int j = 0; j < 4; ++j) gv[j] = ((const f32x4*)P.g_mix)[lane + 64 * j];
    for (int m = gw; m < T_; m += NGW) {
        const f32x4* xr = (const f32x4*)(P.x + (size_t)m * D_) + lane;
        f32x4 v[4]; float s = 0.f;
#pragma unroll
        for (int j = 0; j < 4; ++j) { v[j] = xr[64 * j]; s += (v[j].x * v[j].x + v[j].y * v[j].y) + (v[j].z * v[j].z + v[j].w * v[j].w); }
        const float rstd = 1.0f / sqrtf(wave_sum(s) * (1.0f / D_) + RMS_EPS);
        u32x2* o8 = (u32x2*)(H1 + (size_t)m * D_) + lane;
#pragma unroll
        for (int j = 0; j < 4; ++j) { const f32x4 y = v[j] * rstd * gv[j]; u32x2 w; w.x = pk2(y.x, y.y); w.y = pk2(y.z, y.w); o8[64 * j] = w; }
    }
}

struct AttnState { f32x16 o0, o1; float m, l; };
DI void attn_init(AttnState& st) {
#pragma unroll
    for (int i = 0; i < 16; ++i) { st.o0[i] = 0.f; st.o1[i] = 0.f; }
    st.m = -1e29f; st.l = 0.f;
}
DI void stage_kv(LAS unsigned char* kt, const bf16_t* kbase, const bf16_t* vbase, size_t rowstride, int ptid, int nthr, bool with_v) {
    for (int chunk = ptid; chunk < 512; chunk += nthr) {
        const int key = chunk >> 3, dc = chunk & 7;
        const u32x4 kv = *(const u32x4*)(kbase + (size_t)key * rowstride + dc * 8);
        *(LAS u32x4*)(kt + key * KT_STRIDE + dc * 16) = kv;
        if (with_v) {
            const u32x4 vv = *(const u32x4*)(vbase + (size_t)key * rowstride + dc * 8);
            LAS unsigned char* vt = kt + VT_OFF + (dc * 8) * VT_STRIDE + key * 2;
            *(LAS unsigned short*)(vt + 0 * VT_STRIDE) = (unsigned short)(vv.x & 0xffffu); *(LAS unsigned short*)(vt + 1 * VT_STRIDE) = (unsigned short)(vv.x >> 16);
            *(LAS unsigned short*)(vt + 2 * VT_STRIDE) = (unsigned short)(vv.y & 0xffffu); *(LAS unsigned short*)(vt + 3 * VT_STRIDE) = (unsigned short)(vv.y >> 16);
            *(LAS unsigned short*)(vt + 4 * VT_STRIDE) = (unsigned short)(vv.z & 0xffffu); *(LAS unsigned short*)(vt + 5 * VT_STRIDE) = (unsigned short)(vv.z >> 16);
            *(LAS unsigned short*)(vt + 6 * VT_STRIDE) = (unsigned short)(vv.w & 0xffffu); *(LAS unsigned short*)(vt + 7 * VT_STRIDE) = (unsigned short)(vv.w >> 16);
        }
    }
}
DI void qk_tile(const LAS unsigned char* kt, const bf16x8 (&qf)[4], int r, int h, f32x16& x0, f32x16& x1) {
#pragma unroll
    for (int i = 0; i < 16; ++i) { x0[i] = 0.f; x1[i] = 0.f; }
#pragma unroll
    for (int kk = 0; kk < 4; ++kk) {
        const bf16x8 a0 = *(const LAS bf16x8*)(kt + r * KT_STRIDE + kk * 32 + h * 16);
        const bf16x8 a1 = *(const LAS bf16x8*)(kt + (32 + r) * KT_STRIDE + kk * 32 + h * 16);
        x0 = MFMA32(a0, qf[kk], x0); x1 = MFMA32(a1, qf[kk], x1);
    }
}
DI bf16x8 pack8(const f32x16& x, int s) {
    u32x4 p; p.x = pk2(x[8 * s + 0], x[8 * s + 1]); p.y = pk2(x[8 * s + 2], x[8 * s + 3]); p.z = pk2(x[8 * s + 4], x[8 * s + 5]); p.w = pk2(x[8 * s + 6], x[8 * s + 7]);
    return __builtin_bit_cast(bf16x8, p);
}
template <class MB>
DI void attn_tile(const LAS unsigned char* kt, const bf16x8 (&qf)[4], AttnState& st, int r, int h, MB mb) {
    f32x16 x0, x1;
    qk_tile(kt, qf, r, h, x0, x1);
    float mx = st.m;
#pragma unroll
    for (int i = 0; i < 16; ++i) { const int k0 = crow(i, h); const float a = mb(x0[i], k0), b = mb(x1[i], 32 + k0); x0[i] = a; x1[i] = b; mx = fmaxf(mx, fmaxf(a, b)); }
    mx = fmaxf(mx, __shfl_xor(mx, 32, 64));
    const float alpha = fexp2(st.m - mx); st.m = mx;
    float ls = 0.f;
#pragma unroll
    for (int i = 0; i < 16; ++i) { x0[i] = fexp2(x0[i] - mx); x1[i] = fexp2(x1[i] - mx); ls += x0[i] + x1[i]; }
    st.l = st.l * alpha + ls;
#pragma unroll
    for (int i = 0; i < 16; ++i) { st.o0[i] *= alpha; st.o1[i] *= alpha; }
    const LAS unsigned char* vt = kt + VT_OFF;
#pragma unroll
    for (int kh = 0; kh < 2; ++kh)
#pragma unroll
        for (int s = 0; s < 2; ++s) {
            const bf16x8 pb = kh ? pack8(x1, s) : pack8(x0, s);
            const int keyoff = (32 * kh + 16 * s + 4 * h) * 2;
            { const LAS unsigned char* vp = vt + r * VT_STRIDE + keyoff; const s16x4 lo = *(const LAS s16x4*)vp, hi = *(const LAS s16x4*)(vp + 16);
              const bf16x8 pa = __builtin_shufflevector(lo, hi, 0, 1, 2, 3, 4, 5, 6, 7); st.o0 = MFMA32(pa, pb, st.o0); }
            { const LAS unsigned char* vp = vt + (32 + r) * VT_STRIDE + keyoff; const s16x4 lo = *(const LAS s16x4*)vp, hi = *(const LAS s16x4*)(vp + 16);
              const bf16x8 pa = __builtin_shufflevector(lo, hi, 0, 1, 2, 3, 4, 5, 6, 7); st.o1 = MFMA32(pa, pb, st.o1); }
        }
}

DI void cmp_unit(const Params& P, LAS unsigned char* lds, int u) {
    const int tid = threadIdx.x, w = tid >> 6, lane = tid & 63, r = lane & 31, h = lane >> 5;
    const int which = u >> 6, b = (u >> 4) & 3, g = (u >> 3) & 1, ct = u & 7;
    unsigned char* ws = P.ws;
    const bf16_t* src = (const bf16_t*)(ws + WS_PJKV) + which * 128 + g * 64;
    const float* pe = which ? P.pe_v : P.pe_k;
    const bf16_t* W1t = (const bf16_t*)(ws + (which ? WS_W1V : WS_W1K));
    const bf16_t* W2t = (const bf16_t*)(ws + (which ? WS_W2V : WS_W2K));
    bf16_t* outp = (bf16_t*)(ws + (which ? WS_VC : WS_KC));
    const int cbase = 32 * ct; int c = cbase + r; if (c > 254) c = 254;
    f32x16 acc[4];
#pragma unroll
    for (int nt = 0; nt < 4; ++nt)
#pragma unroll
        for (int i = 0; i < 16; ++i) acc[nt][i] = 0.f;
#pragma unroll 1
    for (int jj = 0; jj < 4; ++jj) {
        const int j = 4 * w + jj; const bf16_t* rowp = src + (size_t)(b * S_ + 16 * c + j) * 768;
#pragma unroll
        for (int kk = 0; kk < 4; ++kk) {
            const int d0 = 16 * kk + 8 * h;
            const u32x4 raw = *(const u32x4*)(rowp + d0);
            const f32x4 p0 = *(const f32x4*)(pe + j * 64 + d0), p1 = *(const f32x4*)(pe + j * 64 + d0 + 4);
            u32x4 av; av.x = pk2(bf2f(raw.x & 0xffffu) + p0[0], bf2f(raw.x >> 16) + p0[1]); av.y = pk2(bf2f(raw.y & 0xffffu) + p0[2], bf2f(raw.y >> 16) + p0[3]);
            av.z = pk2(bf2f(raw.z & 0xffffu) + p1[0], bf2f(raw.z >> 16) + p1[1]); av.w = pk2(bf2f(raw.w & 0xffffu) + p1[2], bf2f(raw.w >> 16) + p1[3]);
            const bf16x8 a = __builtin_bit_cast(bf16x8, av);
#pragma unroll
            for (int nt = 0; nt < 4; ++nt) { const bf16x8 bb = *(const bf16x8*)(W1t + (size_t)(32 * nt + r) * 2048 + j * 64 + d0); acc[nt] = MFMA32(a, bb, acc[nt]); }
        }
    }
    __syncthreads();
    LAS float* part = (LAS float*)lds;
#pragma unroll
    for (int nt = 0; nt < 4; ++nt)
#pragma unroll
        for (int i = 0; i < 16; ++i) part[(w * 32 + crow(i, h)) * 128 + 32 * nt + r] = acc[nt][i];
    __syncthreads();
    LAS unsigned char* hidb = lds + HIDB_OFF;
#pragma unroll
    for (int e = 0; e < 8; ++e) { const int o = tid + 512 * e; float s = 0.f;
#pragma unroll
        for (int ww = 0; ww < 8; ++ww) s += part[ww * 4096 + o];
        const float gl = gelu_tanh(s); const int cl = o >> 7, n = o & 127;
        *(LAS unsigned short*)(hidb + cl * HIDB_STRIDE + n * 2) = (unsigned short)(pk2(gl, 0.f) & 0xffffu); }
    __syncthreads();
    if (w < 2) {
        f32x16 a2;
#pragma unroll
        for (int i = 0; i < 16; ++i) a2[i] = 0.f;
#pragma unroll
        for (int ks = 0; ks < 8; ++ks) { const bf16x8 a = *(const LAS bf16x8*)(hidb + r * HIDB_STRIDE + (16 * ks + 8 * h) * 2);
            const bf16x8 bb = *(const bf16x8*)(W2t + (size_t)(32 * w + r) * 128 + 16 * ks + 8 * h); a2 = MFMA32(a, bb, a2); }
#pragma unroll
        for (int i = 0; i < 16; ++i) outp[((size_t)(b * 2 + g) * 256 + cbase + crow(i, h)) * 64 + 32 * w + r] = (bf16_t)(pk2(a2[i], 0.f) & 0xffffu);
    }
    __syncthreads();
}

DI void dil_unit(const Params& P, LAS unsigned char* lds, int b, int g, int u64) {
    const int tid = threadIdx.x, w = tid >> 6, lane = tid & 63, r = lane & 31, h = lane >> 5;
    const int hh = w >> 1, qh = w & 1;
    const int rd = (g == 0) ? 1 : (g == 1 ? 4 : 16), ntr = 64 / rd, c = u64 / ntr, ut = u64 % ntr;
    const int uq = 64 * ut + 32 * qh + r, tq = c + rd * uq; const size_t trow = (size_t)b * S_ + tq;
    const int head = g * 4 + hh;
    const float sl2 = fexp2(-(float)(head + 1) * (2.0f / 3.0f)) * LOG2E * (float)rd, sc2 = 0.125f * LOG2E;
    unsigned char* ws = P.ws;
    const bf16_t* PJB = (const bf16_t*)(ws + WS_PJB);
    bf16x8 qf[4];
#pragma unroll
    for (int kk = 0; kk < 4; ++kk) qf[kk] = *(const bf16x8*)(PJB + trow * 2304 + g * 256 + hh * 64 + 16 * kk + 8 * h);
    AttnState st; attn_init(st);
    LAS unsigned char* kt = lds + hh * KV_REGION;
    const int kt0 = ut >= 2 ? ut - 2 : 0;
#pragma unroll 1
    for (int t = kt0; t <= ut; ++t) {
        __syncthreads();
        const bf16_t* kb = PJB + ((size_t)b * S_ + c + (size_t)rd * 64 * t) * 2304 + 768 + g * 256 + hh * 64;
        stage_kv(kt, kb, kb + 768, (size_t)rd * 2304, tid & 127, 128, true);
        __syncthreads();
        const int ubase = uq - 64 * t;
        attn_tile(kt, qf, st, r, h, [=](float raw, int key) { const int du = ubase - key; return (du >= 0 && du <= 128) ? raw * sc2 - sl2 * (float)du : -1e30f; });
    }
    const float l = st.l + __shfl_xor(st.l, 32, 64), inv = 1.0f / l;
    bf16_t* od = (bf16_t*)(ws + WS_OD) + ((size_t)g * T_ + trow) * 256 + hh * 64;
#pragma unroll
    for (int gq = 0; gq < 4; ++gq) {
        u32x2 w0; w0.x = pk2(st.o0[4 * gq] * inv, st.o0[4 * gq + 1] * inv); w0.y = pk2(st.o0[4 * gq + 2] * inv, st.o0[4 * gq + 3] * inv);
        *(u32x2*)(od + 8 * gq + 4 * h) = w0;
        u32x2 w1; w1.x = pk2(st.o1[4 * gq] * inv, st.o1[4 * gq + 1] * inv); w1.y = pk2(st.o1[4 * gq + 2] * inv, st.o1[4 * gq + 3] * inv);
        *(u32x2*)(od + 32 + 8 * gq + 4 * h) = w1;
    }
    if (h == 0) ((float*)(ws + WS_LSE))[((size_t)g * T_ + trow) * 4 + hh] = (st.m + __log2f(l)) * LN2;
}

DI void nsa_unit(const Params& P, LAS unsigned char* lds, int b, int g, int i) {
    const int tid = threadIdx.x, w = tid >> 6, lane = tid & 63, r = lane & 31, h = lane >> 5;
    const int rr = w >> 1, qh = w & 1, head = g * 4 + rr;
    const int ql = 32 * qh + r, tq = 64 * i + ql; const size_t trow = (size_t)b * S_ + tq;
    const float sl2 = fexp2(-(float)(head + 1)) * LOG2E, sc2 = 0.125f * LOG2E;
    unsigned char* ws = P.ws;
    const bf16_t* PJQ = (const bf16_t*)(ws + WS_PJQ); const bf16_t* PJKV = (const bf16_t*)(ws + WS_PJKV); const bf16_t* PJG = (const bf16_t*)(ws + WS_PJG);
    bf16x8 qf[4];
#pragma unroll
    for (int kk = 0; kk < 4; ++kk) qf[kk] = *(const bf16x8*)(PJQ + trow * 512 + head * 64 + 16 * kk + 8 * h);
    const float g0 = sigmoidf_(bf2f(PJG[trow * 256 + head * 3 + 0])), g1 = sigmoidf_(bf2f(PJG[trow * 256 + head * 3 + 1])), g2 = sigmoidf_(bf2f(PJG[trow * 256 + head * 3 + 2]));
    LAS unsigned char* kt = lds;
    f32x16 oa0, oa1;
    const int ncmp = 4 * i + 3, ntc = (ncmp + 63) >> 6;
    const bf16_t* KC = (const bf16_t*)(ws + WS_KC) + (size_t)(b * 2 + g) * 256 * 64;
    const bf16_t* VC = (const bf16_t*)(ws + WS_VC) + (size_t)(b * 2 + g) * 256 * 64;
    AttnState st; attn_init(st);
#pragma unroll 1
    for (int t = 0; t < ntc; ++t) {
        __syncthreads();
        stage_kv(kt, KC + (size_t)t * 64 * 64, VC + (size_t)t * 64 * 64, 64, tid, 512, true);
        __syncthreads();
        const int dbase = tq - 31 - 1024 * t;
        attn_tile(kt, qf, st, r, h, [=](float raw, int key) { const int d = dbase - 16 * key; return (d >= 0) ? raw * sc2 - sl2 * (float)d : -1e30f; });
    }
    const float mc = st.m; float lc = st.l + __shfl_xor(st.l, 32, 64); const float invc = lc > 0.f ? 1.0f / lc : 0.f;
    { const float sgc = g0 * invc;
#pragma unroll
      for (int e = 0; e < 16; ++e) { oa0[e] = st.o0[e] * sgc; oa1[e] = st.o1[e] * sgc; } }
    {
        LAS float* imp = (LAS float*)(lds + IMP_OFF) + (rr * 64 + ql) * IMP_QS;
        float carry = 0.f;
#pragma unroll 1
        for (int t = 0; t < ntc; ++t) {
            __syncthreads();
            stage_kv(kt, KC + (size_t)t * 64 * 64, VC, 64, tid, 512, false);
            __syncthreads();
            f32x16 x0, x1; qk_tile(kt, qf, r, h, x0, x1);
            const int dbase = tq - 31 - 1024 * t;
#pragma unroll
            for (int kh = 0; kh < 2; ++kh) {
                float mainv[4], sp[4], recv[4];
#pragma unroll
                for (int gq = 0; gq < 4; ++gq) {
                    float p[4];
#pragma unroll
                    for (int e = 0; e < 4; ++e) { const int key = 32 * kh + 8 * gq + 4 * h + e; const int d = dbase - 16 * key;
                        const float raw = kh ? x1[4 * gq + e] : x0[4 * gq + e];
                        p[e] = (d >= 0) ? fexp2(raw * sc2 - sl2 * (float)d - mc) * invc : 0.f; }
                    mainv[gq] = (p[0] + p[1]) + (p[2] + 0.5f * p[3]); sp[gq] = 0.5f * p[3];
                }
#pragma unroll
                for (int gq = 0; gq < 4; ++gq) recv[gq] = __shfl_xor(sp[gq], 32, 64);
#pragma unroll
                for (int gq = 0; gq < 4; ++gq) { const float add = h ? recv[gq] : (gq ? recv[gq > 0 ? gq - 1 : 0] : carry);
                    imp[16 * t + 8 * kh + 2 * gq + h] = mainv[gq] + add; }
                carry = recv[3];
            }
        }
    }
    __syncthreads();
    {
        LAS unsigned long long* selm = (LAS unsigned long long*)(lds + SEL_OFF);
        LAS unsigned long long* uni = (LAS unsigned long long*)(lds + UNI_OFF);
        unsigned long long un = 0ull;
        if (i <= 15) { const unsigned long long m = (2ull << i) - 1ull; if (lane < 8) selm[8 * w + lane] = m; un = m; }
        else {
            const LAS float* impb = (const LAS float*)(lds + IMP_OFF);
#pragma unroll 1
            for (int qq = 0; qq < 8; ++qq) { const int q = 8 * w + qq;
                const float v = (impb[(0 * 64 + q) * IMP_QS + lane] + impb[(1 * 64 + q) * IMP_QS + lane]) + (impb[(2 * 64 + q) * IMP_QS + lane] + impb[(3 * 64 + q) * IMP_QS + lane]);
                const bool cand = (lane >= 1) && (lane <= i - 1);
                const float key = cand ? v : -2.0f; const int keyi = __float_as_int(key);
                int rank = 0;
#pragma unroll 8
                for (int s2 = 0; s2 < 64; ++s2) { const float o = __int_as_float(__builtin_amdgcn_readlane(keyi, s2)); rank += ((o > key) || (o == key && s2 < lane)) ? 1 : 0; }
                const bool sel = (lane == 0) || (lane == i) || (cand && rank < 14);
                const unsigned long long m = __ballot(sel);
                if (lane == 0) selm[q] = m;
                un |= m; }
        }
        if (lane == 0) uni[w] = un;
    }
    __syncthreads();
    unsigned long long myq, un;
    { const LAS unsigned long long* selm = (const LAS unsigned long long*)(lds + SEL_OFF); const LAS unsigned long long* uni = (const LAS unsigned long long*)(lds + UNI_OFF);
      myq = selm[ql]; un = ((uni[0] | uni[1]) | (uni[2] | uni[3])) | ((uni[4] | uni[5]) | (uni[6] | uni[7])); }
    attn_init(st);
#pragma unroll 1
    for (int s = 0; s <= i; ++s) {
        if (!((un >> s) & 1ull)) continue;
        __syncthreads();
        const bf16_t* kb = PJKV + ((size_t)b * S_ + 64 * s) * 768 + 2 * 128 + g * 64;
        stage_kv(kt, kb, kb + 128, 768, tid, 512, true);
        __syncthreads();
        const bool selq = (myq >> s) & 1ull; const int dbase = tq - 64 * s;
        attn_tile(kt, qf, st, r, h, [=](float raw, int key) { const int d = dbase - key; return (selq && d >= 0) ? raw * sc2 - sl2 * (float)d : -1e30f; });
    }
    { const float l = st.l + __shfl_xor(st.l, 32, 64); const float sg = l > 0.f ? g1 / l : 0.f;
#pragma unroll
      for (int e = 0; e < 16; ++e) { oa0[e] += st.o0[e] * sg; oa1[e] += st.o1[e] * sg; } }
    attn_init(st);
#pragma unroll 1
    for (int s = (i >= 8 ? i - 8 : 0); s <= i; ++s) {
        __syncthreads();
        const bf16_t* kb = PJKV + ((size_t)b * S_ + 64 * s) * 768 + 4 * 128 + g * 64;
        stage_kv(kt, kb, kb + 128, 768, tid, 512, true);
        __syncthreads();
        const int dbase = tq - 64 * s;
        attn_tile(kt, qf, st, r, h, [=](float raw, int key) { const int d = dbase - key; return (d >= 0 && d < 512) ? raw * sc2 - sl2 * (float)d : -1e30f; });
    }
    { const float l = st.l + __shfl_xor(st.l, 32, 64); const float sg = l > 0.f ? g2 / l : 0.f;
#pragma unroll
      for (int e = 0; e < 16; ++e) { oa0[e] += st.o0[e] * sg; oa1[e] += st.o1[e] * sg; } }
    bf16_t* oab = (bf16_t*)P.out + trow * 768 + head * 64;
#pragma unroll
    for (int gq = 0; gq < 4; ++gq) {
        u32x2 w0; w0.x = pk2(oa0[4 * gq], oa0[4 * gq + 1]); w0.y = pk2(oa0[4 * gq + 2], oa0[4 * gq + 3]); *(u32x2*)(oab + 8 * gq + 4 * h) = w0;
        u32x2 w1; w1.x = pk2(oa1[4 * gq], oa1[4 * gq + 1]); w1.y = pk2(oa1[4 * gq + 2], oa1[4 * gq + 3]); *(u32x2*)(oab + 32 + 8 * gq + 4 * h) = w1;
    }
    __syncthreads();
}

#define XB_TMO      128
#define XB_XCNT(j)  (256  + 64 * (j))
#define XB_XSUB(j)  (1280 + 64 * (j))
#define XB_XGEN(j)  (2304 + 64 * (j))
#define XB_TOP      3328
#define XB_TOPGEN   3392
#define XCD_BAR_WORDS 3456
#define XB_SPIN_CAP (1u << 18)
DI unsigned xb_ld(unsigned* p)              { return __hip_atomic_load(p, __ATOMIC_RELAXED, __HIP_MEMORY_SCOPE_AGENT); }
DI unsigned xb_add(unsigned* p, unsigned v) { return __hip_atomic_fetch_add(p, v, __ATOMIC_RELAXED, __HIP_MEMORY_SCOPE_AGENT); }
DI unsigned xb_xcc_id() { return (unsigned)__builtin_amdgcn_s_getreg((3 << 11) | 20) & 0xFu; }
#define XB_SPIN(cond, bar) do { unsigned _sp = 0; while (cond) { __builtin_amdgcn_s_sleep(1); \
    if ((++_sp & 255u) == 0u) { if (xb_ld(&(bar)[XB_TMO])) break; if (_sp > XB_SPIN_CAP) { atomicAdd(&(bar)[XB_TMO], 1u); break; } } } } while (0)
struct XcdBarrier { unsigned* bar; unsigned x; volatile LAS unsigned* st; };
DI void xcd_barrier_complete(unsigned* bar, unsigned x, unsigned& nloc, unsigned& nx) {
    const unsigned G = gridDim.x * gridDim.y * gridDim.z;
    unsigned sum, cnt, mine, sp = 0u;
    for (;;) {
        sum = 0u; cnt = 0u; mine = 0u;
#pragma unroll
        for (unsigned j = 0; j < 16; ++j) { const unsigned c = xb_ld(&bar[XB_XCNT(j)]); sum += c; cnt += (c > 0u) ? 1u : 0u; mine = (j == x) ? c : mine; }
        if (sum == G) break;
        __builtin_amdgcn_s_sleep(1);
        if ((++sp & 255u) == 0u) { if (xb_ld(&bar[XB_TMO])) break; if (sp > XB_SPIN_CAP) { atomicAdd(&bar[XB_TMO], 1u); break; } }
    }
    nloc = mine > 0u ? mine : 1u; nx = cnt > 0u ? cnt : 1u;
}
__device__ __attribute__((noinline)) void xcd_barrier(unsigned* bar, volatile LAS unsigned* st) {
    asm volatile("s_waitcnt vmcnt(0)" ::: "memory");
    __syncthreads();
    if (threadIdx.x == 0) {
        const unsigned x = xb_xcc_id();
        __builtin_amdgcn_s_waitcnt(0);
        unsigned nloc = st[0], nx = st[1];
        if (nloc == 0u) { xcd_barrier_complete(bar, x, nloc, nx); st[0] = nloc; st[1] = nx; }
        const unsigned old = xb_add(&bar[XB_XSUB(x)], 1u);
        const unsigned gen = old / nloc;
        if (old + 1u == (gen + 1u) * nloc) {
            __builtin_amdgcn_fence(__ATOMIC_RELEASE, "agent");
            asm volatile("s_waitcnt vmcnt(0)" ::: "memory");
            const unsigned og = xb_add(&bar[XB_TOP], 1u);
            const unsigned tg = og / nx;
            if (og + 1u == (tg + 1u) * nx) xb_add(&bar[XB_TOPGEN], 1u);
            else XB_SPIN(xb_ld(&bar[XB_TOPGEN]) == tg, bar);
            __builtin_amdgcn_fence(__ATOMIC_ACQUIRE, "agent");
            xb_add(&bar[XB_XGEN(x)], 1u);
            asm volatile("s_waitcnt vmcnt(0)" ::: "memory");
        } else {
            XB_SPIN(xb_ld(&bar[XB_XGEN(x)]) == gen, bar);
            __builtin_amdgcn_fence(__ATOMIC_ACQUIRE, "agent");
            asm volatile("s_waitcnt vmcnt(0)" ::: "memory");
        }
    }
    __syncthreads();
}

DI void ph1(const Params& P, LAS unsigned char* lds, int G, int bid) {
    unsigned char* ws = P.ws;
    pg8::Gemm g{(const bf16_t*)(ws + WS_H1), (const bf16_t*)(ws + WS_WIN), T_, NIN, 1024, 1024, 128}; pg8::StaticOrder S; S.init(T_, NIN, G, bid);
    pg8::EpiProj E{ws}; pg8::gemm_phase(lds, g, S, E);
}
DI void ph2(const Params& P, LAS unsigned char* lds, int G, int bid) {
    for (int u = bid; u < 128 + 768; u += G) {
        if (u < 128) cmp_unit(P, lds, u);
        else { const int v = u - 128; dil_unit(P, lds, v / 192, (v / 64) % 3, v % 64); }
    }
    __syncthreads();
}
DI void ph3(const Params& P, LAS unsigned char* lds, int G, int bid) {
    unsigned char* ws = P.ws; const int tid = threadIdx.x;
    for (int p = bid; p < 256; p += G) { const int b = p >> 6, g = (p >> 5) & 1, ip = p & 31;
        nsa_unit(P, lds, b, g, 63 - ip); nsa_unit(P, lds, b, g, ip); }
    const bf16_t* OD = (const bf16_t*)(ws + WS_OD); const float* LSE = (const float*)(ws + WS_LSE); bf16_t* oab = (bf16_t*)P.out;
    for (int it = bid * 512 + tid; it < T_ * 32; it += G * 512) { const int t = it >> 5, hh = (it >> 3) & 3, dc = it & 7;
        const float l0 = LSE[(size_t)t * 4 + hh], l1 = LSE[((size_t)T_ + t) * 4 + hh], l2 = LSE[((size_t)2 * T_ + t) * 4 + hh];
        const float mx = fmaxf(l0, fmaxf(l1, l2)); const float e0 = __expf(l0 - mx), e1 = __expf(l1 - mx), e2 = __expf(l2 - mx); const float inv = 1.0f / (e0 + e1 + e2);
        f32x4 a0, a1, b0, b1, c0, c1; pg8::load8(OD + (size_t)t * 256 + hh * 64 + dc * 8, a0, a1); pg8::load8(OD + ((size_t)T_ + t) * 256 + hh * 64 + dc * 8, b0, b1);
        pg8::load8(OD + ((size_t)2 * T_ + t) * 256 + hh * 64 + dc * 8, c0, c1);
        const float w0 = e0 * inv, w1 = e1 * inv, w2 = e2 * inv;
        pg8::store8(oab + (size_t)t * 768 + 512 + hh * 64 + dc * 8, a0 * w0 + b0 * w1 + c0 * w2, a1 * w0 + b1 * w1 + c1 * w2); }
}
DI void ph4(const Params& P, LAS unsigned char* lds, int G, int bid) {
    unsigned char* ws = P.ws;
    { pg8::Gemm g{(const bf16_t*)P.out, (const bf16_t*)(ws + WS_WPN), T_, 1024, 512, 768, 128}; pg8::StaticOrder S; S.init(T_, 1024, G, bid);
      pg8::EpiMerge<0> E{(const bf16_t*)(ws + WS_PJM), (bf16_t*)(ws + WS_MIX)}; pg8::gemm_phase(lds, g, S, E); }
    { pg8::Gemm g{(const bf16_t*)P.out + 512, (const bf16_t*)(ws + WS_WPD), T_, 1024, 256, 768, 128}; pg8::StaticOrder S; S.init(T_, 1024, G, bid);
      pg8::EpiMerge<1> E{(const bf16_t*)(ws + WS_PJM), (bf16_t*)(ws + WS_MIX)}; pg8::gemm_phase(lds, g, S, E); }
}
DI void ph5(const Params& P, LAS unsigned char* lds, int G, int bid) {
    unsigned char* ws = P.ws;
    pg8::Gemm g{(const bf16_t*)(ws + WS_MIX), (const bf16_t*)(ws + WS_WOUT), T_, 1024, 1024, 1024, 128}; pg8::StaticOrder S; S.init(T_, 1024, G, bid);
    pg8::EpiResid<1> E{P.x, P.out, (bf16_t*)(ws + WS_A2), P.g_ffn, (float*)(ws + WS_SSQ2)}; pg8::gemm_phase(lds, g, S, E);
}
DI void ph6(const Params& P, LAS unsigned char* lds, int G, int bid) {
    unsigned char* ws = P.ws;
    pg8::Gemm g{(const bf16_t*)(ws + WS_A2), (const bf16_t*)(ws + WS_WUP), T_, NUP, 1024, 1024, 128}; pg8::StaticOrder S; S.init(T_, NUP, G, bid);
    pg8::EpiUp E{(const float*)(ws + WS_SSQ2), (bf16_t*)(ws + WS_UG)}; pg8::gemm_phase(lds, g, S, E);
}
DI void ph7(const Params& P, LAS unsigned char* lds, int G, int bid) {
    unsigned char* ws = P.ws; const int tid = threadIdx.x;
    bf16_t* UG = (bf16_t*)(ws + WS_UG);
    for (int it = bid * 512 + tid; it < (T_ / 8) * 352; it += G * 512) { const int cc = it % 352, tb = it / 352, c0 = cc * 8, t0 = tb * 8;
        const size_t colu = (size_t)(c0 >> 7) * 256 + (c0 & 127);
        const f32x4 wa0 = *(const f32x4*)(P.conv_w + c0), wa1 = *(const f32x4*)(P.conv_w + c0 + 4), wb0 = *(const f32x4*)(P.conv_w + DFF + c0), wb1 = *(const f32x4*)(P.conv_w + DFF + c0 + 4);
        const f32x4 wc0 = *(const f32x4*)(P.conv_w + 2 * DFF + c0), wc1 = *(const f32x4*)(P.conv_w + 2 * DFF + c0 + 4), cb0 = *(const f32x4*)(P.conv_b + c0), cb1 = *(const f32x4*)(P.conv_b + c0 + 4);
        f32x4 um2a = {0.f, 0.f, 0.f, 0.f}, um2b = um2a, um1a = um2a, um1b = um2a;
        if ((t0 & (S_ - 1)) != 0) { pg8::load8(UG + (size_t)(t0 - 2) * NUP + colu, um2a, um2b); pg8::load8(UG + (size_t)(t0 - 1) * NUP + colu, um1a, um1b); }
#pragma unroll 1
        for (int k = 0; k < 8; ++k) { const size_t rowo = (size_t)(t0 + k) * NUP + colu;
            f32x4 ua, ub, ga, gb; pg8::load8(UG + rowo, ua, ub); pg8::load8(UG + rowo + 128, ga, gb);
            f32x4 va = cb0 + wa0 * um2a + wb0 * um1a + wc0 * ua, vb = cb1 + wa1 * um2b + wb1 * um1b + wc1 * ub;
#pragma unroll
            for (int e = 0; e < 4; ++e) { va[e] = gelu_tanh(va[e]) * ga[e]; vb[e] = gelu_tanh(vb[e]) * gb[e]; }
            pg8::store8(UG + rowo + 128, va, vb);
            um2a = um1a; um2b = um1b; um1a = ua; um1b = ub; }
    }
}
DI void ph8(const Params& P, LAS unsigned char* lds, int G, int bid) {
    unsigned char* ws = P.ws;
    pg8::Gemm g{(const bf16_t*)(ws + WS_UG) + 128, (const bf16_t*)(ws + WS_WDN), T_, 1024, DFF, NUP, 256}; pg8::StaticOrder S; S.init(T_, 1024, G, bid);
    pg8::EpiResid<0> E{P.out, P.out, nullptr, nullptr, (float*)(ws + WS_SSQ3)}; pg8::gemm_phase(lds, g, S, E);
}
DI void ph9(const Params& P, LAS unsigned char* lds, int G, int bid) {
    unsigned char* ws = P.ws; const int tid = threadIdx.x;
    const int lane = tid & 63, gw = bid * 8 + (tid >> 6), NGW = G * 8; const float* ssq = (const float*)(ws + WS_SSQ3);
    f32x4 gv[4];
#pragma unroll
    for (int j = 0; j < 4; ++j) gv[j] = ((const f32x4*)P.g_final)[lane + 64 * j];
    for (int m = gw; m < T_; m += NGW) {
        const f32x4* sp = (const f32x4*)(ssq + (size_t)m * 16); const f32x4 st = (sp[0] + sp[1]) + (sp[2] + sp[3]);
        const float rstd = 1.0f / sqrtf(((st[0] + st[1]) + (st[2] + st[3])) * (1.0f / 1024.0f) + RMS_EPS);
        f32x4* xr = (f32x4*)(P.out + (size_t)m * D_) + lane;
#pragma unroll
        for (int j = 0; j < 4; ++j) xr[64 * j] = xr[64 * j] * rstd * gv[j];
    }
}

#ifndef DUP_PHASE
#define DUP_PHASE -1
#endif
__device__ __attribute__((noinline)) void grid_sync_call() { cg::this_grid().sync(); }
__global__ void __launch_bounds__(512, 2) fwd_megakernel(Params P) {
    extern __shared__ __attribute__((aligned(16))) unsigned char lds_raw[];
    LAS unsigned char* lds = (LAS unsigned char*)lds_raw;
    const int G = gridDim.x, bid = blockIdx.x;
    const int lo = P.ph_lo, hi = P.ph_hi;
    unsigned* barw = (unsigned*)(P.ws + WS_CTL); volatile LAS unsigned* stw = (volatile LAS unsigned*)(lds + ST_OFF);
    if (threadIdx.x < 4) stw[threadIdx.x] = 0u;
    if (threadIdx.x == 0) (void)xb_add(&barw[XB_XCNT(xb_xcc_id())], 1u);
    if (lo < 0) grid_sync_call();
    __syncthreads();
#define IN(k) (lo <= (k) && (k) < hi)
#define SEAM(k) do { if (IN(k) && IN((k) + 1)) xcd_barrier(barw, stw); } while (0)
#define PHASE(k, fn) do { if (IN(k)) { fn(P, lds, G, bid); if (DUP_PHASE == (k)) fn(P, lds, G, bid); } SEAM(k); } while (0)
    if (IN(0)) { p0_prologue(P, lds); __syncthreads(); if (DUP_PHASE == 0) { p0_prologue(P, lds); __syncthreads(); } }
    SEAM(0);
    PHASE(1, ph1); PHASE(2, ph2); PHASE(3, ph3); PHASE(4, ph4); PHASE(5, ph5); PHASE(6, ph6); PHASE(7, ph7);
    if (DUP_PHASE == 67) { ph6(P, lds, G, bid); xcd_barrier(barw, stw); ph7(P, lds, G, bid); xcd_barrier(barw, stw); }
    PHASE(8, ph8);
    if (IN(9)) ph9(P, lds, G, bid);
#undef IN
#undef SEAM
#undef PHASE
}

extern "C" void kernel_launch(void* const* d_in, const int* in_sizes, int n_in, void* d_out, int out_size, void* d_ws, size_t ws_size, hipStream_t stream) {
    static int grid = 0;
    if (grid == 0) {
        if (n_in != 18 || ws_size < WS_END) { fprintf(stderr, "kernel_launch: unexpected inputs (n_in %d, ws %zu)\n", n_in, ws_size); grid = -1; return; }
        int dev = 0, cus = 0, per_cu = 0;
        (void)hipGetDevice(&dev); (void)hipDeviceGetAttribute(&cus, hipDeviceAttributeMultiprocessorCount, dev);
        if (hipFuncSetAttribute((const void*)fwd_megakernel, hipFuncAttributeMaxDynamicSharedMemorySize, LDS_BYTES) != hipSuccess) { fprintf(stderr, "hipFuncSetAttribute failed\n"); grid = -1; return; }
        if (hipOccupancyMaxActiveBlocksPerMultiprocessor(&per_cu, (const void*)fwd_megakernel, 512, LDS_BYTES) != hipSuccess || per_cu < 1) per_cu = 1;
        (void)hipGetLastError();
        grid = cus * per_cu;
    }
    if (grid < 0) return;
    if (hipMemsetAsync((char*)d_ws + WS_CTL, 0, CTL_BYTES, stream) != hipSuccess) { fprintf(stderr, "memset failed\n"); return; }
    Params p{};
    const float** f = (const float**)&p;
    for (int i = 0; i < 18; ++i) f[i] = (const float*)d_in[i];
    p.out = (float*)d_out; p.ws = (unsigned char*)d_ws; p.ph_lo = 0; p.ph_hi = 10;
    void* args[] = {&p};
    hipError_t e = hipLaunchCooperativeKernel((const void*)fwd_megakernel, dim3(grid), dim3(512), args, LDS_BYTES, stream);
    if (e != hipSuccess) fprintf(stderr, "cooperative launch failed: %s (grid %d)\n", hipGetErrorString(e), grid);
}
```

```cpp
#include <hip/hip_runtime.h>
#include <hip/hip_cooperative_groups.h>
#include <cstdio>
#include <cstdint>
namespace cg = cooperative_groups;

#define LAS __attribute__((address_space(3)))
#define DI __device__ __forceinline__
typedef unsigned short bf16_t;
typedef short bf16x8 __attribute__((ext_vector_type(8)));
typedef short s16x4 __attribute__((ext_vector_type(4)));
typedef float f32x4 __attribute__((ext_vector_type(4)));
typedef float f32x2 __attribute__((ext_vector_type(2)));
typedef float f32x16 __attribute__((ext_vector_type(16)));
typedef unsigned u32x4 __attribute__((ext_vector_type(4)));
typedef unsigned u32x2 __attribute__((ext_vector_type(2)));
typedef __bf16 bf16x2v __attribute__((ext_vector_type(2)));

constexpr int B_ = 4, S_ = 4096, D_ = 1024, T_ = B_ * S_;
constexpr int NIN = 5888;
constexpr int NINSRC = 5656;
constexpr int DFF = 2816, NUP = 5632;
constexpr float RMS_EPS = 1e-6f;
constexpr float LOG2E = 1.4426950408889634f, LN2 = 0.6931471805599453f;

constexpr size_t MiB = 1u << 20;
constexpr size_t WS_WIN = 0;
constexpr size_t WS_WUP = WS_WIN + (size_t)NIN * 1024 * 2;
constexpr size_t WS_WDN = WS_WUP + (size_t)NUP * 1024 * 2;
constexpr size_t WS_WOUT = WS_WDN + (size_t)1024 * DFF * 2;
constexpr size_t WS_WPN = WS_WOUT + (size_t)1024 * 1024 * 2;
constexpr size_t WS_WPD = WS_WPN + (size_t)1024 * 512 * 2;
constexpr size_t WS_W1K = WS_WPD + (size_t)1024 * 256 * 2;
constexpr size_t WS_W1V = WS_W1K + (size_t)128 * 2048 * 2;
constexpr size_t WS_W2K = WS_W1V + (size_t)128 * 2048 * 2;
constexpr size_t WS_W2V = WS_W2K + (size_t)64 * 128 * 2;
constexpr size_t WS_WEND = WS_W2V + (size_t)64 * 128 * 2;
constexpr size_t WS_R1 = 33 * MiB;
constexpr size_t WS_PJQ = WS_R1, WS_PJKV = WS_R1 + 16 * MiB, WS_PJB = WS_R1 + 40 * MiB, WS_PJM = WS_R1 + 112 * MiB, WS_PJG = WS_R1 + 176 * MiB;
constexpr size_t WS_MIX = WS_R1;
constexpr size_t WS_UG = WS_R1;
constexpr size_t WS_R2 = 217 * MiB;
constexpr size_t WS_H1 = WS_R2, WS_OD = WS_R2, WS_LSE = WS_R2 + 24 * MiB, WS_A2 = WS_R2;
constexpr size_t WS_KC = 249 * MiB, WS_VC = WS_KC + 262144, WS_CTL = WS_KC + 524288, CTL_BYTES = 16384, WS_SSQ2 = 250 * MiB, WS_SSQ3 = 250 * MiB;
constexpr size_t SIDE_BYTES = (size_t)64 * 2 * DFF * 4, WS_ULAST = 251 * MiB, WS_UFIRST = WS_ULAST + SIDE_BYTES, WS_GFIRST = WS_UFIRST + SIDE_BYTES, WS_END = WS_GFIRST + SIDE_BYTES;
constexpr size_t WS_ACT = WS_R1;
static_assert(WS_END <= 256 * MiB, "ws");
static_assert(WS_WEND <= WS_R1, "weights");

constexpr int LDS_BYTES = 147456;
constexpr int KT_STRIDE = 144, VT_STRIDE = 136, VT_OFF = 64 * KT_STRIDE, KV_REGION = VT_OFF + 64 * VT_STRIDE;
constexpr int IMP_OFF = 73728, IMP_QS = 65, IMP_BYTES = 4 * 64 * IMP_QS * 4;
constexpr int SEL_OFF = IMP_OFF + IMP_BYTES, UNI_OFF = SEL_OFF + 512;
static_assert(UNI_OFF + 64 <= LDS_BYTES, "lds");
constexpr int HIDB_OFF = 131072, HIDB_STRIDE = 272;
constexpr int MXT_OFF = 36864, SPL_OFF = 40960;
static_assert(2 * KV_REGION <= MXT_OFF && SPL_OFF + 4096 <= IMP_OFF, "lds nsa");
constexpr int ST_OFF = LDS_BYTES - 16;

struct Params {
    const float *x, *g_mix, *w_in, *pe_k, *w_k1, *w_k2, *pe_v, *w_v1, *w_v2, *w_pn, *w_pd, *w_out, *g_ffn, *w_up, *conv_w, *conv_b, *w_down, *g_final;
    float* out; unsigned char* ws; int ph_lo, ph_hi;
};

DI float bf2f(unsigned v) { return __builtin_bit_cast(float, v << 16); }
DI unsigned pk2(float a, float b) { f32x2 v = {a, b}; return __builtin_bit_cast(unsigned, __builtin_convertvector(v, bf16x2v)); }
DI float wave_sum(float v) {
#pragma unroll
    for (int o = 1; o < 64; o <<= 1) v += __shfl_xor(v, o, 64);
    return v;
}
DI float fexp2(float x) { return __builtin_amdgcn_exp2f(x); }
DI float sigmoidf_(float x) { return __builtin_amdgcn_rcpf(1.0f + fexp2(-LOG2E * x)); }
DI float gelu_tanh(float x) {
    const float t = x * x;
    const float u = __builtin_fmaf(t, -2.0f * LOG2E * 0.7978845608028654f * 0.044715f, -2.0f * LOG2E * 0.7978845608028654f);
    const float e = fexp2(x * u);
    return x * __builtin_amdgcn_rcpf(1.0f + e);
}
DI int crow(int i, int h) { return (i & 3) + 8 * (i >> 2) + 4 * h; }
#define MFMA32(a, b, c) __builtin_amdgcn_mfma_f32_32x32x16_bf16((a), (b), (c), 0, 0, 0)

namespace pg8 {
constexpr int BM = 256, BK = 64, HALF = 128, HTB = HALF * BK * 2, NXCD = 8, WGM = 8;
DI int lds_byte(int r, int c) { const int st = (r >> 4) * 2 + (c >> 5), rr = r & 15, cc = c & 31, ob = rr * 64 + cc * 2; return st * 1024 + (ob ^ (((ob >> 9) & 1) << 5)); }
DI void stage_rc(int b, int& R, int& C) { const int st = b / 1024, sb = b % 1024, swz = sb ^ (((sb >> 9) & 1) << 5); R = (st >> 1) * 16 + swz / 64; C = (st & 1) * 32 + (swz % 64) / 2; }
DI int perm32(int rho) { const int n = rho >> 4, i = rho & 15; return 8 * (i >> 2) + 4 * n + (i & 3); }
struct Unit { int pm, pn, idx; };
struct Gemm { const bf16_t* A; const bf16_t* Bt; int M, N, K, lda, apair; };
struct StaticOrder {
    int nM, nN, nwg, G, c;
    DI void init(int M, int N, int G_, int c_) { nM = M / BM; nN = N / BM; nwg = nM * nN; G = G_; c = c_; }
    DI bool next(int i, Unit& u) const {
        const long L = (long)i * G + c; if (L >= nwg) return false;
        int wgid = (int)L; { const int q = nwg / NXCD, r = nwg % NXCD, xcd = wgid % NXCD, off = wgid / NXCD; wgid = (xcd < r ? xcd * (q + 1) : r * (q + 1) + (xcd - r) * q) + off; }
        const int nig = WGM * nN, gid = wgid / nig, fm = gid * WGM, gsz = (nM - fm) < WGM ? (nM - fm) : WGM;
        u.pm = fm + ((wgid % nig) % gsz); u.pn = (wgid % nig) / gsz; u.idx = i; return true;
    }
};
template <class Epi, int HOOK_T = -1>
DI void gemm_phase(LAS unsigned char* lds, const Gemm g, const StaticOrder& S, const Epi& E) {
    const int tid = threadIdx.x, wid = __builtin_amdgcn_readfirstlane(tid >> 6), lane = tid & 63, wr = wid >> 2, wc = wid & 3, fr = lane & 15, fq = lane >> 4;
    const int K = g.K, nt = K / BK, lda = g.lda;
    unsigned voffA[2], voffB[2];
#pragma unroll
    for (int i = 0; i < 2; ++i) { int R, C; stage_rc(tid * 16 + i * 8192, R, C); const int Rb = (R & ~31) + perm32(R & 31);
        voffA[i] = (unsigned)(R * lda + C) * 2u; voffB[i] = (unsigned)(Rb * K + C) * 2u; }
    const size_t kstep = (size_t)(BK * 2);
    const size_t apairB = (size_t)g.apair * 2;
    const size_t hstepA = (size_t)HALF * lda * 2, tstepA = 2 * hstepA;
    const size_t hstepB = (size_t)HALF * K * 2, tstepB = 2 * hstepB;
    const unsigned ldsw = (unsigned)wid * 1024u;
    const int aoff = lds_byte(wr * 64 + fr, fq * 8), boff = lds_byte(wc * 32 + fr, fq * 8);
#define PG8_SA(b, h) (((b) * 2 + (h)) * HTB)
#define PG8_SB(b, h) ((4 + (b) * 2 + (h)) * HTB)
#define PG8_STAGE(bufoff, gbase, voff) do { _Pragma("unroll") for (int _i = 0; _i < 2; ++_i) \
        __builtin_amdgcn_global_load_lds((const unsigned*)((const char*)(gbase) + (voff)[_i]), (LAS unsigned*)(lds + (bufoff) + ldsw + _i * 8192), 16, 0, 0); } while (0)
#define PG8_LDA(dst, b, h) do { _Pragma("unroll") for (int m = 0; m < 4; ++m) _Pragma("unroll") for (int k = 0; k < 2; ++k) dst[m][k] = *(const LAS bf16x8*)(lds + PG8_SA(b, h) + aoff + m * 2048 + k * 1024); } while (0)
#define PG8_LDB(dst, b, h) do { _Pragma("unroll") for (int n = 0; n < 2; ++n) _Pragma("unroll") for (int k = 0; k < 2; ++k) dst[n][k] = *(const LAS bf16x8*)(lds + PG8_SB(b, h) + boff + n * 2048 + k * 1024); } while (0)
#define PG8_MMA(ai, bj, At, Bt) do { __builtin_amdgcn_s_setprio(1); _Pragma("unroll") for (int m = 0; m < 4; ++m) _Pragma("unroll") for (int n = 0; n < 2; ++n) _Pragma("unroll") for (int k = 0; k < 2; ++k) \
        acc[ai][bj][m][n] = __builtin_amdgcn_mfma_f32_16x16x32_bf16(Bt[n][k], At[m][k], acc[ai][bj][m][n], 0, 0, 0); __builtin_amdgcn_s_setprio(0); } while (0)
#define PG8_WAIT_V(n) asm volatile("s_waitcnt vmcnt(" #n ")" ::: "memory")
#define PG8_WAIT_L(n) asm volatile("s_waitcnt lgkmcnt(" #n ")" ::: "memory")
#define PG8_BAR __builtin_amdgcn_s_barrier()
#define PG8_SCHED __builtin_amdgcn_sched_barrier(0)
    Unit cur, nxt; int ui = 0;
    if (!S.next(0, cur)) return;
    f32x4 acc[2][2][4][2];
#pragma unroll
    for (int a = 0; a < 2; ++a)
#pragma unroll
        for (int b = 0; b < 2; ++b)
#pragma unroll
            for (int m = 0; m < 4; ++m)
#pragma unroll
                for (int n = 0; n < 2; ++n) acc[a][b][m][n] = (f32x4){0.f, 0.f, 0.f, 0.f};
    bf16x8 At[4][2], B0[2][2], B1[2][2];
    const char* cA = (const char*)g.A + (size_t)cur.pm * tstepA; const char* cB = (const char*)g.Bt + (size_t)cur.pn * tstepB;
    PG8_STAGE(PG8_SB(0, 0), cB, voffB); PG8_STAGE(PG8_SB(0, 1), cB + hstepB, voffB); PG8_STAGE(PG8_SA(0, 0), cA, voffA); PG8_STAGE(PG8_SA(0, 1), cA + hstepA, voffA);
    if (wr == 1) PG8_BAR;
    PG8_WAIT_V(2); PG8_BAR;
    PG8_STAGE(PG8_SB(1, 0), cB + kstep, voffB); PG8_STAGE(PG8_SA(1, 0), cA + kstep, voffA); PG8_STAGE(PG8_SB(1, 1), cB + hstepB + kstep, voffB);
    PG8_WAIT_V(6); PG8_BAR;
    for (;;) {
        const bool has_next = S.next(ui + 1, nxt);
        const char* nA = has_next ? (const char*)g.A + (size_t)nxt.pm * tstepA : cA; const char* nB = has_next ? (const char*)g.Bt + (size_t)nxt.pn * tstepB : cB;
        for (int t = 0; t < nt; t += 2) {
            const bool last = (t == nt - 2);
            const char* a1 = cA + (size_t)(t >> 1) * apairB + kstep;
            const char* a2 = last ? nA : cA + (size_t)((t >> 1) + 1) * apairB; const char* b2 = last ? nB : cB + (size_t)(t + 2) * kstep;
            const char* a3 = a2 + kstep; const char* b3 = b2 + kstep;
            PG8_LDB(B0, 0, 0); PG8_LDB(B1, 0, 1); PG8_SCHED; PG8_LDA(At, 0, 0); PG8_STAGE(PG8_SA(1, 1), a1 + hstepA, voffA);
            PG8_WAIT_V(8); PG8_WAIT_L(0); PG8_BAR; PG8_MMA(0, 0, At, B0); PG8_MMA(0, 1, At, B1); PG8_BAR; PG8_SCHED;
            PG8_LDA(At, 0, 1); PG8_STAGE(PG8_SB(0, 0), b2, voffB); PG8_STAGE(PG8_SB(0, 1), b2 + hstepB, voffB); PG8_STAGE(PG8_SA(0, 0), a2, voffA);
            PG8_WAIT_V(8); PG8_WAIT_L(0); PG8_BAR; PG8_MMA(1, 0, At, B0); PG8_MMA(1, 1, At, B1); PG8_BAR; PG8_SCHED;
            PG8_LDB(B0, 1, 0); PG8_LDB(B1, 1, 1); PG8_SCHED; PG8_LDA(At, 1, 0); PG8_STAGE(PG8_SA(0, 1), a2 + hstepA, voffA);
            PG8_WAIT_V(8); PG8_WAIT_L(0); PG8_BAR; PG8_MMA(0, 0, At, B0); PG8_MMA(0, 1, At, B1); PG8_BAR; PG8_SCHED;
            PG8_LDA(At, 1, 1); PG8_STAGE(PG8_SB(1, 0), b3, voffB); PG8_STAGE(PG8_SB(1, 1), b3 + hstepB, voffB); PG8_STAGE(PG8_SA(1, 0), a3, voffA);
            PG8_WAIT_V(8); PG8_WAIT_L(0); PG8_BAR; PG8_MMA(1, 0, At, B0); PG8_MMA(1, 1, At, B1); PG8_BAR; PG8_SCHED;
            if constexpr (HOOK_T >= 0) { if (t == HOOK_T) { E.hook(acc, cur, wr, wc, fr, fq); PG8_SCHED; } }
        }
        if (wr == 0) PG8_BAR;
        E(acc, cur, wr, wc, fr, fq);
        if (!has_next) break;
#pragma unroll
        for (int a = 0; a < 2; ++a)
#pragma unroll
            for (int b = 0; b < 2; ++b)
#pragma unroll
                for (int m = 0; m < 4; ++m)
#pragma unroll
                    for (int n = 0; n < 2; ++n) acc[a][b][m][n] = (f32x4){0.f, 0.f, 0.f, 0.f};
        cur = nxt; cA = nA; cB = nB; ++ui;
        if (wr == 1) PG8_BAR;
    }
    PG8_WAIT_V(0);
    PG8_BAR;
#undef PG8_SA
#undef PG8_SB
#undef PG8_STAGE
#undef PG8_LDA
#undef PG8_LDB
#undef PG8_MMA
#undef PG8_WAIT_V
#undef PG8_WAIT_L
#undef PG8_BAR
#undef PG8_SCHED
}
typedef f32x4 Acc[2][2][4][2];
DI void store8(bf16_t* p, f32x4 v0, f32x4 v1) { u32x4 w; w.x = pk2(v0[0], v0[1]); w.y = pk2(v0[2], v0[3]); w.z = pk2(v1[0], v1[1]); w.w = pk2(v1[2], v1[3]); *(u32x4*)p = w; }
DI void load8(const bf16_t* p, f32x4& v0, f32x4& v1) { const u32x4 w = *(const u32x4*)p;
    v0 = (f32x4){bf2f(w.x & 0xffffu), bf2f(w.x >> 16), bf2f(w.y & 0xffffu), bf2f(w.y >> 16)}; v1 = (f32x4){bf2f(w.z & 0xffffu), bf2f(w.z >> 16), bf2f(w.w & 0xffffu), bf2f(w.w >> 16)}; }

struct EpiProj {
    unsigned char* ws;
    DI void operator()(Acc& acc, const Unit& u, int wr, int wc, int fr, int fq) const {
        const int pn = u.pn; bf16_t* base; int ld, ct;
        if (pn < 2) { base = (bf16_t*)(ws + WS_PJQ); ld = 512; ct = pn; }
        else if (pn < 5) { base = (bf16_t*)(ws + WS_PJKV); ld = 768; ct = pn - 2; }
        else if (pn < 14) { base = (bf16_t*)(ws + WS_PJB); ld = 2304; ct = pn - 5; }
        else if (pn < 22) { base = (bf16_t*)(ws + WS_PJM); ld = 2048; ct = pn - 14; }
        else { base = (bf16_t*)(ws + WS_PJG); ld = 256; ct = 0; }
        const int row0 = u.pm * BM + wr * 64 + fr, col0 = ct * 256 + wc * 32 + 8 * fq;
#pragma unroll
        for (int ai = 0; ai < 2; ++ai)
#pragma unroll
            for (int m = 0; m < 4; ++m) { bf16_t* rowp = base + (size_t)(row0 + ai * HALF + m * 16) * ld + col0;
#pragma unroll
                for (int bj = 0; bj < 2; ++bj) { f32x4 v0 = acc[ai][bj][m][0], v1 = acc[ai][bj][m][1];
                    if (pn >= 14 && pn < 22) {
#pragma unroll
                        for (int e = 0; e < 4; ++e) { v0[e] = sigmoidf_(v0[e]); v1[e] = sigmoidf_(v1[e]); } }
                    store8(rowp + bj * HALF, v0, v1); } }
    }
};
struct EpiMerge {
    const bf16_t* gate; bf16_t* mix;
    DI void hook(Acc& acc, const Unit& u, int wr, int wc, int fr, int fq) const {
        asm volatile("" : "+v"(fr), "+v"(fq));
        const int row0 = u.pm * BM + wr * 64 + fr, col0 = u.pn * BM + wc * 32 + 8 * fq;
#pragma unroll
        for (int ai = 0; ai < 2; ++ai)
#pragma unroll
            for (int m = 0; m < 4; ++m) { const size_t row = (size_t)(row0 + ai * HALF + m * 16);
#pragma unroll
                for (int bj = 0; bj < 2; ++bj) { const int col = col0 + bj * HALF;
                    f32x4 a0, a1, b0, b1; load8(gate + row * 2048 + col, a0, a1); load8(gate + row * 2048 + 1024 + col, b0, b1);
#pragma unroll
                    for (int e = 0; e < 4; ++e) { acc[ai][bj][m][0][e] *= a0[e] * __builtin_amdgcn_rcpf(b0[e]); acc[ai][bj][m][1][e] *= a1[e] * __builtin_amdgcn_rcpf(b1[e]); } }
                asm volatile("" ::: "memory"); }
    }
    DI void operator()(Acc& acc, const Unit& u, int wr, int wc, int fr, int fq) const {
        const int row0 = u.pm * BM + wr * 64 + fr, col0 = u.pn * BM + wc * 32 + 8 * fq;
        u32x4 cg[2], ng[2];
#pragma unroll
        for (int bj = 0; bj < 2; ++bj) cg[bj] = *(const u32x4*)(gate + (size_t)row0 * 2048 + 1024 + col0 + bj * HALF);
#pragma unroll
        for (int g = 0; g < 8; ++g) { const int ai = g >> 2, m = g & 3; const size_t row = (size_t)(row0 + ai * HALF + m * 16);
            if (g < 7) { const size_t row2 = (size_t)(row0 + ((g + 1) >> 2) * HALF + ((g + 1) & 3) * 16);
#pragma unroll
                for (int bj = 0; bj < 2; ++bj) ng[bj] = *(const u32x4*)(gate + row2 * 2048 + 1024 + col0 + bj * HALF); }
#pragma unroll
            for (int bj = 0; bj < 2; ++bj) { const u32x4 w = cg[bj];
                const f32x4 b0 = {bf2f(w.x & 0xffffu), bf2f(w.x >> 16), bf2f(w.y & 0xffffu), bf2f(w.y >> 16)}, b1 = {bf2f(w.z & 0xffffu), bf2f(w.z >> 16), bf2f(w.w & 0xffffu), bf2f(w.w >> 16)};
                store8(mix + row * 1024 + col0 + bj * HALF, acc[ai][bj][m][0] * b0, acc[ai][bj][m][1] * b1); }
            cg[0] = ng[0]; cg[1] = ng[1]; }
    }
};
template <int WRITE_A2> struct EpiResid {
    const float* xi; float* xo; bf16_t* a2; const float* gw; float* ssq;
    DI void operator()(Acc& acc, const Unit& u, int wr, int wc, int fr, int fq) const {
        const int row0 = u.pm * BM + wr * 64 + fr, col0 = u.pn * BM + wc * 32 + 8 * fq;
        f32x4 cx[4], nx[4], wg[4];
#pragma unroll
        for (int bj = 0; bj < 2; ++bj) { const float* p = xi + (size_t)row0 * 1024 + col0 + bj * HALF; cx[2 * bj] = *(const f32x4*)p; cx[2 * bj + 1] = *(const f32x4*)(p + 4);
            if (WRITE_A2) { wg[2 * bj] = *(const f32x4*)(gw + col0 + bj * HALF); wg[2 * bj + 1] = *(const f32x4*)(gw + col0 + bj * HALF + 4); } }
#pragma unroll
        for (int g = 0; g < 8; ++g) { const int ai = g >> 2, m = g & 3; const size_t row = (size_t)(row0 + ai * HALF + m * 16); float ss = 0.f;
            if (g < 7) { const int ai2 = (g + 1) >> 2, m2 = (g + 1) & 3; const size_t row2 = (size_t)(row0 + ai2 * HALF + m2 * 16);
#pragma unroll
                for (int bj = 0; bj < 2; ++bj) { const float* p = xi + row2 * 1024 + col0 + bj * HALF; nx[2 * bj] = *(const f32x4*)p; nx[2 * bj + 1] = *(const f32x4*)(p + 4); } }
#pragma unroll
            for (int bj = 0; bj < 2; ++bj) { const int col = col0 + bj * HALF;
                const f32x4 v0 = acc[ai][bj][m][0] + cx[2 * bj], v1 = acc[ai][bj][m][1] + cx[2 * bj + 1];
                *(f32x4*)(xo + row * 1024 + col) = v0; *(f32x4*)(xo + row * 1024 + col + 4) = v1;
                ss += (v0[0] * v0[0] + v0[1] * v0[1]) + (v0[2] * v0[2] + v0[3] * v0[3]) + (v1[0] * v1[0] + v1[1] * v1[1]) + (v1[2] * v1[2] + v1[3] * v1[3]);
                if (WRITE_A2) store8(a2 + row * 1024 + col, v0 * wg[2 * bj], v1 * wg[2 * bj + 1]); }
            ss += __shfl_xor(ss, 16, 64); ss += __shfl_xor(ss, 32, 64);
            if (fq == 0) ssq[row * 16 + u.pn * 4 + wc] = ss;
#pragma unroll
            for (int q = 0; q < 4; ++q) cx[q] = nx[q]; }
    }
};
struct EpiFinal {
    const float* xi; float* xo; const float* gw; float* ssq; unsigned* cnt; LAS unsigned char* xlds;
    DI void operator()(Acc& acc, const Unit& u, int wr, int wc, int fr, int fq) const {
        asm volatile("" : "+v"(fr), "+v"(fq));
        const int lane = fr + 16 * fq, t = (wr * 4 + wc) * 64 + lane;
        const int row0 = u.pm * BM + wr * 64 + fr, col0 = u.pn * BM + wc * 32 + 8 * fq;
        f32x4 cx[4], nx[4];
#pragma unroll
        for (int bj = 0; bj < 2; ++bj) { const float* p = xi + (size_t)row0 * 1024 + col0 + bj * HALF; cx[2 * bj] = *(const f32x4*)p; cx[2 * bj + 1] = *(const f32x4*)(p + 4); }
#pragma unroll
        for (int g = 0; g < 8; ++g) { const int ai = g >> 2, m = g & 3; const size_t row = (size_t)(row0 + ai * HALF + m * 16); float ss = 0.f;
            if (g < 7) { const size_t row2 = (size_t)(row0 + ((g + 1) >> 2) * HALF + ((g + 1) & 3) * 16);
#pragma unroll
                for (int bj = 0; bj < 2; ++bj) { const float* p = xi + row2 * 1024 + col0 + bj * HALF; nx[2 * bj] = *(const f32x4*)p; nx[2 * bj + 1] = *(const f32x4*)(p + 4); } }
#pragma unroll
            for (int bj = 0; bj < 2; ++bj) { const f32x4 v0 = acc[ai][bj][m][0] + cx[2 * bj], v1 = acc[ai][bj][m][1] + cx[2 * bj + 1];
                acc[ai][bj][m][0] = v0; acc[ai][bj][m][1] = v1;
                ss += (v0[0] * v0[0] + v0[1] * v0[1]) + (v0[2] * v0[2] + v0[3] * v0[3]) + (v1[0] * v1[0] + v1[1] * v1[1]) + (v1[2] * v1[2] + v1[3] * v1[3]); }
            ss += __shfl_xor(ss, 16, 64); ss += __shfl_xor(ss, 32, 64);
            if (fq == 0) ssq[row * 16 + u.pn * 4 + wc] = ss;
#pragma unroll
            for (int q = 0; q < 4; ++q) cx[q] = nx[q]; }
        f32x4 gwv[4];
#pragma unroll
        for (int bj = 0; bj < 2; ++bj) { gwv[2 * bj] = *(const f32x4*)(gw + col0 + bj * HALF); gwv[2 * bj + 1] = *(const f32x4*)(gw + col0 + bj * HALF + 4); }
        asm volatile("s_waitcnt vmcnt(0)" ::: "memory");
        __syncthreads();
        if (t == 0) {
            __builtin_amdgcn_fence(__ATOMIC_RELEASE, "agent"); asm volatile("s_waitcnt vmcnt(0)" ::: "memory");
            (void)__hip_atomic_fetch_add(cnt + u.pm, 1u, __ATOMIC_RELAXED, __HIP_MEMORY_SCOPE_AGENT);
            unsigned sp = 0;
            while (__hip_atomic_load(cnt + u.pm, __ATOMIC_RELAXED, __HIP_MEMORY_SCOPE_AGENT) < 4u) { __builtin_amdgcn_s_sleep(1); if (++sp > (1u << 22)) break; }
            __builtin_amdgcn_fence(__ATOMIC_ACQUIRE, "agent"); asm volatile("s_waitcnt vmcnt(0)" ::: "memory");
        }
        __syncthreads();
        LAS float* rs = (LAS float*)xlds;
        if (t < 256) { const f32x4* sp = (const f32x4*)(ssq + (size_t)(u.pm * BM + t) * 16); const f32x4 st = (sp[0] + sp[1]) + (sp[2] + sp[3]);
            rs[t] = 1.0f / sqrtf(((st[0] + st[1]) + (st[2] + st[3])) * (1.0f / 1024.0f) + RMS_EPS); }
        __syncthreads();
#pragma unroll
        for (int ai = 0; ai < 2; ++ai)
#pragma unroll
            for (int m = 0; m < 4; ++m) { const int rl = ai * HALF + wr * 64 + m * 16 + fr; const size_t row = (size_t)(u.pm * BM + rl); const float rstd = rs[rl];
#pragma unroll
                for (int bj = 0; bj < 2; ++bj) { const int col = col0 + bj * HALF;
                    *(f32x4*)(xo + row * 1024 + col) = acc[ai][bj][m][0] * rstd * gwv[2 * bj]; *(f32x4*)(xo + row * 1024 + col + 4) = acc[ai][bj][m][1] * rstd * gwv[2 * bj + 1]; } }
    }
};
DI void store4(bf16_t* p, f32x4 v) { u32x2 w; w.x = pk2(v[0], v[1]); w.y = pk2(v[2], v[3]); *(u32x2*)p = w; }
struct EpiUpConv {
    const float* ssq; bf16_t* act; const float* conv_w; const float* conv_b; float* ulast; float* ufirst; float* gfirst; LAS unsigned char* xlds;
    DI void operator()(Acc& acc, const Unit& u, int wr, int wc, int fr, int fq) const {
        asm volatile("" : "+v"(fr), "+v"(fq));
        const int lane = fr + 16 * fq;
        const int colg = u.pn * 128 + wc * 32 + 8 * fq;
        LAS float* xs = (LAS float*)xlds;
        const LAS float* rs = (const LAS float*)(xlds + 8192) + u.idx * 256;
#pragma unroll
        for (int ai = 0; ai < 2; ++ai)
#pragma unroll
            for (int m = 0; m < 4; ++m) { const float rstd = rs[ai * HALF + wr * 64 + m * 16 + fr];
#pragma unroll
                for (int bj = 0; bj < 2; ++bj)
#pragma unroll
                    for (int n = 0; n < 2; ++n) acc[ai][bj][m][n] *= rstd; }
        if (fr >= 14) {
#pragma unroll
            for (int ai = 0; ai < 2; ++ai) { LAS float* slot = xs + ((((ai * 2 + wr) * 4 + wc) * 2 + (fr - 14)) * 4 + fq) * 8;
                *(LAS f32x4*)slot = acc[ai][0][3][0]; *(LAS f32x4*)(slot + 4) = acc[ai][0][3][1]; }
            if (wr == 1) { float* p = ulast + ((size_t)u.pm * 2 + (fr - 14)) * DFF + colg; *(f32x4*)p = acc[1][0][3][0]; *(f32x4*)(p + 4) = acc[1][0][3][1]; }
        }
        if (fr < 2 && wr == 0) { float* p = ufirst + ((size_t)u.pm * 2 + fr) * DFF + colg; *(f32x4*)p = acc[0][0][0][0]; *(f32x4*)(p + 4) = acc[0][0][0][1];
            float* q = gfirst + ((size_t)u.pm * 2 + fr) * DFF + colg; *(f32x4*)q = acc[0][1][0][0]; *(f32x4*)(q + 4) = acc[0][1][0][1]; }
        __syncthreads();
#pragma unroll
        for (int n = 0; n < 2; ++n) {
            const f32x4 w0 = *(const f32x4*)(conv_w + colg + 4 * n), w1 = *(const f32x4*)(conv_w + DFF + colg + 4 * n), w2 = *(const f32x4*)(conv_w + 2 * DFF + colg + 4 * n), cb = *(const f32x4*)(conv_b + colg + 4 * n);
#pragma unroll
            for (int ai = 0; ai < 2; ++ai) {
                f32x4 r1p = {0.f, 0.f, 0.f, 0.f}, r2p = r1p;
                if (ai == 1 || wr == 1) { const int pai = wr ? ai : ai - 1, pwr = wr ? 0 : 1;
                    const f32x4 p1 = *(const LAS f32x4*)(xs + ((((pai * 2 + pwr) * 4 + wc) * 2 + 1) * 4 + fq) * 8 + 4 * n), p2 = *(const LAS f32x4*)(xs + ((((pai * 2 + pwr) * 4 + wc) * 2 + 0) * 4 + fq) * 8 + 4 * n);
                    r1p = p1; r2p = fr == 0 ? p2 : p1; }
#pragma unroll
                for (int m = 0; m < 4; ++m) {
                    const f32x4 ua = acc[ai][0][m][n];
                    f32x4 r1, r2;
#pragma unroll
                    for (int e = 0; e < 4; ++e) { r1[e] = __int_as_float(__builtin_amdgcn_update_dpp(0, __float_as_int(ua[e]), 0x121, 0xf, 0xf, false));
                        r2[e] = __int_as_float(__builtin_amdgcn_update_dpp(0, __float_as_int(ua[e]), 0x122, 0xf, 0xf, false)); }
                    const f32x4 pv1 = fr >= 1 ? r1 : r1p, pv2 = fr >= 2 ? r2 : r2p;
                    f32x4 v = cb + w0 * pv2 + w1 * pv1 + w2 * ua;
                    const f32x4 ga = acc[ai][1][m][n];
#pragma unroll
                    for (int e = 0; e < 4; ++e) v[e] = gelu_tanh(v[e]) * ga[e];
                    const bool skip = (ai == 0 && m == 0 && wr == 0 && fr < 2);
                    if (!skip) store4(act + (size_t)(u.pm * BM + ai * HALF + wr * 64 + m * 16 + fr) * DFF + colg + 4 * n, v);
                    r1p = r1; r2p = r2;
                    asm volatile("" ::: "memory");
                }
            }
        }
    }
};
struct EpiNull { DI void operator()(Acc& acc, const Unit& u, int wr, int wc, int fr, int fq) const { if (acc[0][0][0][0][0] == 1234.5f) *(volatile int*)nullptr = 0; } };
}

#ifndef DUP_PHASE
#define DUP_PHASE -1
#endif
DI int rowmap(int mode, int n) {
    if (mode == 1) { if (n < 1280) return n; if (n < 1304) return 5632 + (n - 1280); return n - 24; }
    if (mode == 2) { if (n < DFF) return (n >> 7) * 256 + (n & 127); const int q = n - DFF; return (q >> 7) * 256 + 128 + (q & 127); }
    return n;
}
DI void transpose_item(const float* W, int K, int N, bf16_t* WT, int ldt, int mode, LAS float* scr, int item, int lane) {
    const int nblk = (N + 31) / 32, kb = item / nblk, nb = item % nblk, k0 = 64 * kb, n0 = 32 * nb;
    const int nl = n0 + (lane & 31);
    float tv[32];
    const float* wp = W + (size_t)(k0 + (lane >> 5)) * N + (nl < N ? nl : 0);
#pragma unroll
    for (int i = 0; i < 32; ++i) tv[i] = wp[(size_t)(2 * i) * N];
#pragma unroll
    for (int i = 0; i < 32; ++i) scr[(2 * i + (lane >> 5)) * 33 + (lane & 31)] = tv[i];
    asm volatile("s_waitcnt lgkmcnt(0)" ::: "memory");
    const int c = lane & 7;
#pragma unroll
    for (int j = 0; j < 4; ++j) { const int n = (lane >> 3) + 8 * j; const LAS float* s = scr + (8 * c) * 33 + n;
        u32x4 o; o.x = pk2(s[0 * 33], s[1 * 33]); o.y = pk2(s[2 * 33], s[3 * 33]); o.z = pk2(s[4 * 33], s[5 * 33]); o.w = pk2(s[6 * 33], s[7 * 33]);
        if (n0 + n < N) *(u32x4*)(WT + (size_t)rowmap(mode, n0 + n) * ldt + k0 + 8 * c) = o; }
    asm volatile("s_waitcnt lgkmcnt(0)" ::: "memory");
}
DI void p0_prologue(const Params& P, LAS unsigned char* lds) {
    const int tid = threadIdx.x, lane = tid & 63, wave = tid >> 6;
    LAS float* scr = (LAS float*)(lds + wave * 16384);
    const int gw = blockIdx.x * 8 + wave, NGW = gridDim.x * 8;
    unsigned char* ws = P.ws;
    int base = 0;
#define DOJOB(W_, K_, N_, OFF_, MODE_, LDT_) do { const int items = ((K_) / 64) * (((N_) + 31) / 32); \
        int first = gw - (base % NGW); if (first < 0) first += NGW; \
        for (int it = first; it < items; it += NGW) transpose_item((W_), (K_), (N_), (bf16_t*)(ws + (OFF_)), (LDT_), (MODE_), scr, it, lane); \
        base += items; } while (0)
    DOJOB(P.w_in, 1024, NINSRC, WS_WIN, 1, 1024); DOJOB(P.w_up, 1024, NUP, WS_WUP, 2, 1024); DOJOB(P.w_down, DFF, 1024, WS_WDN, 0, DFF); DOJOB(P.w_out, 1024, 1024, WS_WOUT, 0, 1024);
    DOJOB(P.w_pn, 512, 1024, WS_WPN, 0, 768); DOJOB(P.w_pd, 256, 1024, WS_WPN + 1024, 0, 768); DOJOB(P.w_k1, 2048, 128, WS_W1K, 0, 2048); DOJOB(P.w_v1, 2048, 128, WS_W1V, 0, 2048);
    DOJOB(P.w_k2, 128, 64, WS_W2K, 0, 128); DOJOB(P.w_v2, 128, 64, WS_W2V, 0, 128);
#undef DOJOB
    { u32x4* z = (u32x4*)(ws + WS_WIN + (size_t)NINSRC * 1024 * 2); const int n16 = (NIN - NINSRC) * 1024 * 2 / 16;
      for (int i = blockIdx.x * 512 + tid; i < n16; i += gridDim.x * 512) z[i] = (u32x4){0u, 0u, 0u, 0u}; }
    bf16_t* H1 = (bf16_t*)(ws + WS_H1);
    f32x4 gv[4];
#pragma unroll
    for (int j = 0; j < 4; ++j) gv[j] = ((const f32x4*)P.g_mix)[lane + 64 * j];
    for (int m0 = gw * 4; m0 < T_; m0 += NGW * 4) {
        f32x4 v[4][4]; float ss[4];
#pragma unroll
        for (int q = 0; q < 4; ++q) { const f32x4* xr = (const f32x4*)(P.x + (size_t)(m0 + q) * D_) + lane;
#pragma unroll
            for (int j = 0; j < 4; ++j) v[q][j] = xr[64 * j]; }
#pragma unroll
        for (int q = 0; q < 4; ++q) { float s = 0.f;
#pragma unroll
            for (int j = 0; j < 4; ++j) s += (v[q][j].x * v[q][j].x + v[q][j].y * v[q][j].y) + (v[q][j].z * v[q][j].z + v[q][j].w * v[q][j].w);
            ss[q] = s; }
#pragma unroll
        for (int o = 1; o < 64; o <<= 1) {
#pragma unroll
            for (int q = 0; q < 4; ++q) ss[q] += __shfl_xor(ss[q], o, 64); }
#pragma unroll
        for (int q = 0; q < 4; ++q) { const float rstd = 1.0f / sqrtf(ss[q] * (1.0f / D_) + RMS_EPS);
            u32x2* o8 = (u32x2*)(H1 + (size_t)(m0 + q) * D_) + lane;
#pragma unroll
            for (int j = 0; j < 4; ++j) { const f32x4 y = v[q][j] * rstd * gv[j]; u32x2 w; w.x = pk2(y.x, y.y); w.y = pk2(y.z, y.w); o8[64 * j] = w; } }
    }
}

struct AttnState { f32x16 o0, o1; float m, l; };
DI void attn_init(AttnState& st) {
#pragma unroll
    for (int i = 0; i < 16; ++i) { st.o0[i] = 0.f; st.o1[i] = 0.f; }
    st.m = -1e29f; st.l = 0.f;
}
DI void stage_kv(LAS unsigned char* kt, const bf16_t* kbase, const bf16_t* vbase, size_t rowstride, int ptid, int nthr, bool with_v) {
    for (int chunk = ptid; chunk < 512; chunk += nthr) {
        const int key = chunk >> 3, dc = chunk & 7;
        const u32x4 kv = *(const u32x4*)(kbase + (size_t)key * rowstride + dc * 8);
        *(LAS u32x4*)(kt + key * KT_STRIDE + dc * 16) = kv;
        if (with_v) {
            const u32x4 vv = *(const u32x4*)(vbase + (size_t)key * rowstride + dc * 8);
            LAS unsigned char* vt = kt + VT_OFF + (dc * 8) * VT_STRIDE + key * 2;
            *(LAS unsigned short*)(vt + 0 * VT_STRIDE) = (unsigned short)(vv.x & 0xffffu); *(LAS unsigned short*)(vt + 1 * VT_STRIDE) = (unsigned short)(vv.x >> 16);
            *(LAS unsigned short*)(vt + 2 * VT_STRIDE) = (unsigned short)(vv.y & 0xffffu); *(LAS unsigned short*)(vt + 3 * VT_STRIDE) = (unsigned short)(vv.y >> 16);
            *(LAS unsigned short*)(vt + 4 * VT_STRIDE) = (unsigned short)(vv.z & 0xffffu); *(LAS unsigned short*)(vt + 5 * VT_STRIDE) = (unsigned short)(vv.z >> 16);
            *(LAS unsigned short*)(vt + 6 * VT_STRIDE) = (unsigned short)(vv.w & 0xffffu); *(LAS unsigned short*)(vt + 7 * VT_STRIDE) = (unsigned short)(vv.w >> 16);
        }
    }
}
template <int NCH> struct KVRegs { u32x4 k[NCH], v[NCH]; };
template <int NCH> DI void kv_load(KVRegs<NCH>& R, const bf16_t* kbase, const bf16_t* vbase, size_t rowstride, int ptid, bool with_v) {
#pragma unroll
    for (int j = 0; j < NCH; ++j) { const int chunk = ptid + j * (512 / NCH), key = chunk >> 3, dc = chunk & 7;
        R.k[j] = *(const u32x4*)(kbase + (size_t)key * rowstride + dc * 8);
        if (with_v) R.v[j] = *(const u32x4*)(vbase + (size_t)key * rowstride + dc * 8); }
}
template <int NCH> DI void kv_store(const KVRegs<NCH>& R, LAS unsigned char* kt, int ptid, bool with_v) {
#pragma unroll
    for (int j = 0; j < NCH; ++j) { const int chunk = ptid + j * (512 / NCH), key = chunk >> 3, dc = chunk & 7;
        *(LAS u32x4*)(kt + key * KT_STRIDE + dc * 16) = R.k[j];
        if (with_v) { const u32x4 vv = R.v[j];
            LAS unsigned char* vt = kt + VT_OFF + (dc * 8) * VT_STRIDE + key * 2;
            *(LAS unsigned short*)(vt + 0 * VT_STRIDE) = (unsigned short)(vv.x & 0xffffu); *(LAS unsigned short*)(vt + 1 * VT_STRIDE) = (unsigned short)(vv.x >> 16);
            *(LAS unsigned short*)(vt + 2 * VT_STRIDE) = (unsigned short)(vv.y & 0xffffu); *(LAS unsigned short*)(vt + 3 * VT_STRIDE) = (unsigned short)(vv.y >> 16);
            *(LAS unsigned short*)(vt + 4 * VT_STRIDE) = (unsigned short)(vv.z & 0xffffu); *(LAS unsigned short*)(vt + 5 * VT_STRIDE) = (unsigned short)(vv.z >> 16);
            *(LAS unsigned short*)(vt + 6 * VT_STRIDE) = (unsigned short)(vv.w & 0xffffu); *(LAS unsigned short*)(vt + 7 * VT_STRIDE) = (unsigned short)(vv.w >> 16); } }
}
template <int NCH, class Body>
DI void run_tiles(LAS unsigned char* buf0, const bf16_t* kb0, const bf16_t* vb0, size_t rowstride, size_t tilestride, unsigned long long mask, int ptid, bool with_v, Body body) {
    if (mask == 0ull) return;
    KVRegs<NCH> R;
    int s = __builtin_ctzll(mask); mask &= mask - 1ull;
    kv_load<NCH>(R, kb0 + (size_t)s * tilestride, vb0 + (size_t)s * tilestride, rowstride, ptid, with_v);
    __syncthreads();
    kv_store<NCH>(R, buf0, ptid, with_v);
    int sn = -1;
    if (mask) { sn = __builtin_ctzll(mask); mask &= mask - 1ull; kv_load<NCH>(R, kb0 + (size_t)sn * tilestride, vb0 + (size_t)sn * tilestride, rowstride, ptid, with_v); }
    __syncthreads();
    int cur = 0;
    for (;;) {
        body(buf0 + cur * KV_REGION, s);
        if (sn < 0) break;
        kv_store<NCH>(R, buf0 + (cur ^ 1) * KV_REGION, ptid, with_v);
        s = sn;
        if (mask) { sn = __builtin_ctzll(mask); mask &= mask - 1ull; kv_load<NCH>(R, kb0 + (size_t)sn * tilestride, vb0 + (size_t)sn * tilestride, rowstride, ptid, with_v); } else sn = -1;
        __syncthreads();
        cur ^= 1;
    }
}
DI void qk_tile(const LAS unsigned char* kt, const bf16x8 (&qf)[4], int r, int h, f32x16& x0, f32x16& x1) {
#pragma unroll
    for (int kk = 0; kk < 4; ++kk) {
        const bf16x8 a0 = *(const LAS bf16x8*)(kt + r * KT_STRIDE + kk * 32 + h * 16);
        const bf16x8 a1 = *(const LAS bf16x8*)(kt + (32 + r) * KT_STRIDE + kk * 32 + h * 16);
        x0 = MFMA32(a0, qf[kk], x0); x1 = MFMA32(a1, qf[kk], x1);
    }
}
DI void bias_init(f32x16& x0, f32x16& x1, float slm, float b0) {
#pragma unroll
    for (int i = 0; i < 16; ++i) { const float c = (float)((i & 3) + 8 * (i >> 2)); x0[i] = __builtin_fmaf(slm, c, b0); x1[i] = __builtin_fmaf(slm, c + 32.0f, b0); }
}
DI bf16x8 pack8(const f32x16& x, int s) {
    u32x4 p; p.x = pk2(x[8 * s + 0], x[8 * s + 1]); p.y = pk2(x[8 * s + 2], x[8 * s + 3]); p.z = pk2(x[8 * s + 4], x[8 * s + 5]); p.w = pk2(x[8 * s + 6], x[8 * s + 7]);
    return __builtin_bit_cast(bf16x8, p);
}
DI bf16x8 scale_q8(bf16x8 q) {
    const u32x4 w = __builtin_bit_cast(u32x4, q); u32x4 o;
    o.x = pk2(bf2f(w.x & 0xffffu) * 0.125f, bf2f(w.x >> 16) * 0.125f); o.y = pk2(bf2f(w.y & 0xffffu) * 0.125f, bf2f(w.y >> 16) * 0.125f);
    o.z = pk2(bf2f(w.z & 0xffffu) * 0.125f, bf2f(w.z >> 16) * 0.125f); o.w = pk2(bf2f(w.w & 0xffffu) * 0.125f, bf2f(w.w >> 16) * 0.125f);
    return __builtin_bit_cast(bf16x8, o);
}
struct NoPost { DI void operator()(const f32x16&, const f32x16&, float) const {} };
template <class VF, class PH = NoPost>
DI void attn_tile_dyn(bool MASKED, const LAS unsigned char* kt, const bf16x8 (&qf)[4], AttnState& st, int r, int h, float slm, float b0, VF valid, PH post = PH()) {
    f32x16 x0, x1;
    bias_init(x0, x1, slm, b0);
    qk_tile(kt, qf, r, h, x0, x1);
    if (MASKED) {
#pragma unroll
        for (int i = 0; i < 16; ++i) { const int k0 = crow(i, h); x0[i] = valid(k0) ? x0[i] : -1e30f; x1[i] = valid(32 + k0) ? x1[i] : -1e30f; }
    }
    float mxa = fmaxf(x0[0], x1[0]), mxb = fmaxf(x0[1], x1[1]);
#pragma unroll
    for (int i = 2; i < 16; i += 2) { mxa = fmaxf(fmaxf(mxa, x0[i]), x1[i]); mxb = fmaxf(fmaxf(mxb, x0[i + 1]), x1[i + 1]); }
    float mx = fmaxf(fmaxf(st.m, mxa), mxb);
    { const unsigned mu = __float_as_uint(mx); const auto sw = __builtin_amdgcn_permlane32_swap(mu, mu, false, false);
      mx = fmaxf(__uint_as_float(sw[0]), __uint_as_float(sw[1])); }
    const float alpha = fexp2((st.m - mx) * LOG2E); st.m = mx;
    const float nm = -mx * LOG2E;
    float ls = 0.f;
#pragma unroll
    for (int i = 0; i < 16; ++i) { x0[i] = fexp2(__builtin_fmaf(x0[i], LOG2E, nm)); x1[i] = fexp2(__builtin_fmaf(x1[i], LOG2E, nm)); ls += x0[i] + x1[i]; }
    st.l = st.l * alpha + ls;
    post(x0, x1, mx);
#pragma unroll
    for (int i = 0; i < 16; ++i) { st.o0[i] *= alpha; st.o1[i] *= alpha; }
    const LAS unsigned char* vt = kt + VT_OFF;
#pragma unroll
    for (int kh = 0; kh < 2; ++kh)
#pragma unroll
        for (int s = 0; s < 2; ++s) {
            const bf16x8 pb = kh ? pack8(x1, s) : pack8(x0, s);
            const int keyoff = (32 * kh + 16 * s + 4 * h) * 2;
            { const LAS unsigned char* vp = vt + r * VT_STRIDE + keyoff; const s16x4 lo = *(const LAS s16x4*)vp, hi = *(const LAS s16x4*)(vp + 16);
              const bf16x8 pa = __builtin_shufflevector(lo, hi, 0, 1, 2, 3, 4, 5, 6, 7); st.o0 = MFMA32(pa, pb, st.o0); }
            { const LAS unsigned char* vp = vt + (32 + r) * VT_STRIDE + keyoff; const s16x4 lo = *(const LAS s16x4*)vp, hi = *(const LAS s16x4*)(vp + 16);
              const bf16x8 pa = __builtin_shufflevector(lo, hi, 0, 1, 2, 3, 4, 5, 6, 7); st.o1 = MFMA32(pa, pb, st.o1); }
        }
}
DI void cmp_unit(const Params& P, LAS unsigned char* lds, int u) {
    int tid = threadIdx.x; asm volatile("" : "+v"(tid));
    const int w = __builtin_amdgcn_readfirstlane(tid >> 6), lane = tid & 63, r = lane & 31, h = lane >> 5;
    const int which = u >> 6, b = (u >> 4) & 3, g = (u >> 3) & 1, ct = u & 7;
    unsigned char* ws = P.ws;
    const bf16_t* src = (const bf16_t*)(ws + WS_PJKV) + which * 128 + g * 64;
    const float* pe = which ? P.pe_v : P.pe_k;
    const bf16_t* W1t = (const bf16_t*)(ws + (which ? WS_W1V : WS_W1K));
    const bf16_t* W2t = (const bf16_t*)(ws + (which ? WS_W2V : WS_W2K));
    bf16_t* outp = (bf16_t*)(ws + (which ? WS_VC : WS_KC));
    const int cbase = 32 * ct; int c = cbase + r; if (c > 254) c = 254;
    f32x16 acc[4];
#pragma unroll
    for (int nt = 0; nt < 4; ++nt)
#pragma unroll
        for (int i = 0; i < 16; ++i) acc[nt][i] = 0.f;
#pragma unroll 1
    for (int jj = 0; jj < 4; ++jj) {
        const int j = 4 * w + jj; const bf16_t* rowp = src + (size_t)(b * S_ + 16 * c + j) * 768;
#pragma unroll
        for (int kk = 0; kk < 4; ++kk) {
            const int d0 = 16 * kk + 8 * h;
            const u32x4 raw = *(const u32x4*)(rowp + d0);
            const f32x4 p0 = *(const f32x4*)(pe + j * 64 + d0), p1 = *(const f32x4*)(pe + j * 64 + d0 + 4);
            u32x4 av; av.x = pk2(bf2f(raw.x & 0xffffu) + p0[0], bf2f(raw.x >> 16) + p0[1]); av.y = pk2(bf2f(raw.y & 0xffffu) + p0[2], bf2f(raw.y >> 16) + p0[3]);
            av.z = pk2(bf2f(raw.z & 0xffffu) + p1[0], bf2f(raw.z >> 16) + p1[1]); av.w = pk2(bf2f(raw.w & 0xffffu) + p1[2], bf2f(raw.w >> 16) + p1[3]);
            const bf16x8 a = __builtin_bit_cast(bf16x8, av);
#pragma unroll
            for (int nt = 0; nt < 4; ++nt) { const bf16x8 bb = *(const bf16x8*)(W1t + (size_t)(32 * nt + r) * 2048 + j * 64 + d0); acc[nt] = MFMA32(a, bb, acc[nt]); }
        }
    }
    __syncthreads();
    LAS float* part = (LAS float*)lds;
#pragma unroll
    for (int nt = 0; nt < 4; ++nt)
#pragma unroll
        for (int i = 0; i < 16; ++i) part[(w * 32 + crow(i, h)) * 128 + 32 * nt + r] = acc[nt][i];
    __syncthreads();
    LAS unsigned char* hidb = lds + HIDB_OFF;
#pragma unroll
    for (int e = 0; e < 8; ++e) { const int o = tid + 512 * e; float s = 0.f;
#pragma unroll
        for (int ww = 0; ww < 8; ++ww) s += part[ww * 4096 + o];
        const float gl = gelu_tanh(s); const int cl = o >> 7, n = o & 127;
        *(LAS unsigned short*)(hidb + cl * HIDB_STRIDE + n * 2) = (unsigned short)(pk2(gl, 0.f) & 0xffffu); }
    __syncthreads();
    if (w < 2) {
        f32x16 a2;
#pragma unroll
        for (int i = 0; i < 16; ++i) a2[i] = 0.f;
#pragma unroll
        for (int ks = 0; ks < 8; ++ks) { const bf16x8 a = *(const LAS bf16x8*)(hidb + r * HIDB_STRIDE + (16 * ks + 8 * h) * 2);
            const bf16x8 bb = *(const bf16x8*)(W2t + (size_t)(32 * w + r) * 128 + 16 * ks + 8 * h); a2 = MFMA32(a, bb, a2); }
#pragma unroll
        for (int i = 0; i < 16; ++i) outp[((size_t)(b * 2 + g) * 256 + cbase + crow(i, h)) * 64 + 32 * w + r] = (bf16_t)(pk2(a2[i], 0.f) & 0xffffu);
    }
    __syncthreads();
}

DI void dil_unit(const Params& P, LAS unsigned char* lds, int b, int g, int u64) {
    int tid = threadIdx.x; asm volatile("" : "+v"(tid));
    const int w = __builtin_amdgcn_readfirstlane(tid >> 6), lane = tid & 63, r = lane & 31, h = lane >> 5;
    const int hh = w >> 1, qh = w & 1;
    const int rd = (g == 0) ? 1 : (g == 1 ? 4 : 16), ntr = 64 / rd, c = u64 / ntr, ut = u64 % ntr;
    const int uq = 64 * ut + 32 * qh + r, tq = c + rd * uq; const size_t trow = (size_t)b * S_ + tq;
    const int head = g * 4 + hh;
    const float slm = fexp2(-(float)(head + 1) * (2.0f / 3.0f)) * (float)rd;
    unsigned char* ws = P.ws;
    const bf16_t* PJB = (const bf16_t*)(ws + WS_PJB);
    bf16x8 qf[4];
#pragma unroll
    for (int kk = 0; kk < 4; ++kk) qf[kk] = scale_q8(*(const bf16x8*)(PJB + trow * 2304 + g * 256 + hh * 64 + 16 * kk + 8 * h));
    AttnState st; attn_init(st);
    const int kt0 = ut >= 2 ? ut - 2 : 0;
    const unsigned long long tmask = ((2ull << ut) - 1ull) & ~((1ull << kt0) - 1ull);
    const bf16_t* kb0 = PJB + ((size_t)b * S_ + c) * 2304 + 768 + g * 256 + hh * 64;
    run_tiles<4>(lds + hh * 2 * KV_REGION, kb0, kb0 + 768, (size_t)rd * 2304, (size_t)rd * 64 * 2304, tmask, tid & 127, true,
        [&](const LAS unsigned char* kt, int t) { const int ubase = uq - 64 * t;
            attn_tile_dyn(t == ut || t + 2 == ut, kt, qf, st, r, h, slm, slm * (float)(4 * h - ubase), [=](int key) { const int du = ubase - key; return du >= 0 && du <= 128; }); });
    const float l = st.l + __shfl_xor(st.l, 32, 64), inv = 1.0f / l;
    bf16_t* od = (bf16_t*)(ws + WS_OD) + ((size_t)g * T_ + trow) * 256 + hh * 64;
#pragma unroll
    for (int gq = 0; gq < 4; ++gq) {
        u32x2 w0; w0.x = pk2(st.o0[4 * gq] * inv, st.o0[4 * gq + 1] * inv); w0.y = pk2(st.o0[4 * gq + 2] * inv, st.o0[4 * gq + 3] * inv);
        *(u32x2*)(od + 8 * gq + 4 * h) = w0;
        u32x2 w1; w1.x = pk2(st.o1[4 * gq] * inv, st.o1[4 * gq + 1] * inv); w1.y = pk2(st.o1[4 * gq + 2] * inv, st.o1[4 * gq + 3] * inv);
        *(u32x2*)(od + 32 + 8 * gq + 4 * h) = w1;
    }
    if (h == 0) ((float*)(ws + WS_LSE))[((size_t)g * T_ + trow) * 4 + hh] = st.m + __log2f(l) * LN2;
}

DI void nsa_unit(const Params& P, LAS unsigned char* lds, int b, int g, int i) {
    int tid = threadIdx.x; asm volatile("" : "+v"(tid));
    const int w = __builtin_amdgcn_readfirstlane(tid >> 6), lane = tid & 63, r = lane & 31, h = lane >> 5;
    const int rr = w >> 1, qh = w & 1, head = g * 4 + rr;
    const int ql = 32 * qh + r, tq = 64 * i + ql; const size_t trow = (size_t)b * S_ + tq;
    const float slope = fexp2(-(float)(head + 1));
    unsigned char* ws = P.ws;
    const bf16_t* PJQ = (const bf16_t*)(ws + WS_PJQ); const bf16_t* PJKV = (const bf16_t*)(ws + WS_PJKV); const bf16_t* PJG = (const bf16_t*)(ws + WS_PJG);
    bf16x8 qf[4];
#pragma unroll
    for (int kk = 0; kk < 4; ++kk) qf[kk] = scale_q8(*(const bf16x8*)(PJQ + trow * 512 + head * 64 + 16 * kk + 8 * h));
    const float g0 = sigmoidf_(bf2f(PJG[trow * 256 + head * 3 + 0])), g1 = sigmoidf_(bf2f(PJG[trow * 256 + head * 3 + 1])), g2 = sigmoidf_(bf2f(PJG[trow * 256 + head * 3 + 2]));
    LAS unsigned char* kt = lds;
    f32x16 oa0, oa1;
    const int ncmp = 4 * i + 3, ntc = (ncmp + 63) >> 6;
    const bf16_t* KC = (const bf16_t*)(ws + WS_KC) + (size_t)(b * 2 + g) * 256 * 64;
    const bf16_t* VC = (const bf16_t*)(ws + WS_VC) + (size_t)(b * 2 + g) * 256 * 64;
    AttnState st; attn_init(st);
    const unsigned long long cmask = (1ull << ntc) - 1ull;
    const bool need_imp = i > 15;
    LAS float* imp = (LAS float*)(lds + IMP_OFF) + (rr * 64 + ql) * IMP_QS;
    LAS float* mxt = (LAS float*)(lds + MXT_OFF) + (rr * 64 + ql) * 4;
    LAS float* spl = (LAS float*)(lds + SPL_OFF) + (rr * 64 + ql) * 4;
    run_tiles<1>(kt, KC, VC, 64, 64 * 64, cmask, tid, true, [&](const LAS unsigned char* kb, int t) {
        const int dbase = tq - 31 - 1024 * t;
        attn_tile_dyn(64 * i - 31 - 1024 * t < 1008, kb, qf, st, r, h, 16.0f * slope, slope * (float)(64 * h - dbase), [=](int key) { return dbase - 16 * key >= 0; },
            [&](const f32x16& p0, const f32x16& p1, float mx) {
                if (!need_imp) return;
                float carry = 0.f;
#pragma unroll
                for (int kh = 0; kh < 2; ++kh) {
                    float mainv[4], sp[4], recv[4];
#pragma unroll
                    for (int gq = 0; gq < 4; ++gq) { const float a = kh ? p1[4 * gq] : p0[4 * gq], bq = kh ? p1[4 * gq + 1] : p0[4 * gq + 1], c = kh ? p1[4 * gq + 2] : p0[4 * gq + 2], d = kh ? p1[4 * gq + 3] : p0[4 * gq + 3];
                        mainv[gq] = (a + bq) + (c + 0.5f * d); sp[gq] = 0.5f * d; }
#pragma unroll
                    for (int gq = 0; gq < 4; ++gq) recv[gq] = __shfl_xor(sp[gq], 32, 64);
#pragma unroll
                    for (int gq = 0; gq < 4; ++gq) { const float add = h ? recv[gq] : (gq ? recv[gq > 0 ? gq - 1 : 0] : carry);
                        imp[16 * t + 8 * kh + 2 * gq + h] = mainv[gq] + add; }
                    carry = recv[3];
                }
                if (h == 0) { mxt[t] = mx; if (t < 3) spl[t + 1] = carry; }
            }); });
    const float mc = st.m; float lc = st.l + __shfl_xor(st.l, 32, 64); const float invc = lc > 0.f ? 1.0f / lc : 0.f;
    { const float sgc = g0 * invc;
#pragma unroll
      for (int e = 0; e < 16; ++e) { oa0[e] = st.o0[e] * sgc; oa1[e] = st.o1[e] * sgc; } }
    if (need_imp && h == 0) {
#pragma unroll 1
        for (int t = 0; t < ntc; ++t) mxt[t] = fexp2((mxt[t] - mc) * LOG2E) * invc;
    }
    __syncthreads();
    {
        LAS unsigned long long* selm = (LAS unsigned long long*)(lds + SEL_OFF);
        LAS unsigned long long* uni = (LAS unsigned long long*)(lds + UNI_OFF);
        unsigned long long un = 0ull;
        if (i <= 15) { const unsigned long long m = (2ull << i) - 1ull; if (lane < 8) selm[8 * w + lane] = m; un = m; }
        else {
            const LAS float* impb = (const LAS float*)(lds + IMP_OFF);
            const LAS float* fac = (const LAS float*)(lds + MXT_OFF); const LAS float* spb = (const LAS float*)(lds + SPL_OFF);
            const int tl = lane >> 4; const bool head16 = (lane & 15) == 0 && lane > 0;
            const bool cand = (lane >= 1) && (lane <= i - 1);
#pragma unroll 1
            for (int qq = 0; qq < 8; qq += 2) {
                float v[2];
#pragma unroll
                for (int z = 0; z < 2; ++z) { const int q = 8 * w + qq + z; float acc = 0.f;
#pragma unroll
                    for (int hd = 0; hd < 4; ++hd) { const int fo = (hd * 64 + q) * 4;
                        acc += impb[(hd * 64 + q) * IMP_QS + lane] * fac[fo + tl];
                        if (head16) acc += spb[fo + tl] * fac[fo + tl - 1]; }
                    v[z] = acc; }
                const unsigned kb0 = __float_as_uint(v[0]), kb1 = __float_as_uint(v[1]);
                unsigned T0 = 0u, T1 = 0u;
#pragma unroll 1
                for (int bb = 30; bb >= 0; --bb) { const unsigned Tn0 = T0 | (1u << bb), Tn1 = T1 | (1u << bb);
                    const int c0 = __popcll(__ballot(cand && kb0 >= Tn0)), c1 = __popcll(__ballot(cand && kb1 >= Tn1));
                    if (c0 >= 14) T0 = Tn0; if (c1 >= 14) T1 = Tn1; }
#pragma unroll
                for (int z = 0; z < 2; ++z) { const unsigned kb = z ? kb1 : kb0, T = z ? T1 : T0;
                    const unsigned long long gtm = __ballot(cand && kb > T), eqm = __ballot(cand && kb == T);
                    const int need = 14 - __popcll(gtm);
                    const bool seleq = ((eqm >> lane) & 1ull) && (__popcll(eqm & ((1ull << lane) - 1ull)) < need);
                    const bool sel = (lane == 0) || (lane == i) || (cand && kb > T) || seleq;
                    const unsigned long long m = __ballot(sel);
                    if (lane == 0) selm[8 * w + qq + z] = m;
                    un |= m; } }
        }
        if (lane == 0) uni[w] = un;
    }
    __syncthreads();
    unsigned long long myq, un;
    { const LAS unsigned long long* selm = (const LAS unsigned long long*)(lds + SEL_OFF); const LAS unsigned long long* uni = (const LAS unsigned long long*)(lds + UNI_OFF);
      myq = selm[ql]; un = ((uni[0] | uni[1]) | (uni[2] | uni[3])) | ((uni[4] | uni[5]) | (uni[6] | uni[7])); }
    attn_init(st);
    { const bf16_t* kb0 = PJKV + (size_t)b * S_ * 768 + 2 * 128 + g * 64;
      run_tiles<1>(kt, kb0, kb0 + 128, 768, 64 * 768, un & ((2ull << i) - 1ull), tid, true, [&](const LAS unsigned char* kb, int s) {
        const bool selq = (myq >> s) & 1ull; const int dbase = tq - 64 * s;
        attn_tile_dyn(s == i, kb, qf, st, r, h, slope, selq ? slope * (float)(4 * h - dbase) : -1e30f, [=](int key) { return dbase - key >= 0; }); }); }
    { const float l = st.l + __shfl_xor(st.l, 32, 64); const float sg = l > 0.f ? g1 / l : 0.f;
#pragma unroll
      for (int e = 0; e < 16; ++e) { oa0[e] += st.o0[e] * sg; oa1[e] += st.o1[e] * sg; } }
    attn_init(st);
    { const bf16_t* kb0 = PJKV + (size_t)b * S_ * 768 + 4 * 128 + g * 64; const int s0 = i >= 8 ? i - 8 : 0;
      run_tiles<1>(kt, kb0, kb0 + 128, 768, 64 * 768, ((2ull << i) - 1ull) & ~((1ull << s0) - 1ull), tid, true, [&](const LAS unsigned char* kb, int s) {
        const int dbase = tq - 64 * s;
        attn_tile_dyn(s == i || s + 8 == i, kb, qf, st, r, h, slope, slope * (float)(4 * h - dbase), [=](int key) { const int d = dbase - key; return d >= 0 && d < 512; }); }); }
    { const float l = st.l + __shfl_xor(st.l, 32, 64); const float sg = l > 0.f ? g2 / l : 0.f;
#pragma unroll
      for (int e = 0; e < 16; ++e) { oa0[e] += st.o0[e] * sg; oa1[e] += st.o1[e] * sg; } }
    bf16_t* oab = (bf16_t*)P.out + trow * 768 + head * 64;
#pragma unroll
    for (int gq = 0; gq < 4; ++gq) {
        u32x2 w0; w0.x = pk2(oa0[4 * gq], oa0[4 * gq + 1]); w0.y = pk2(oa0[4 * gq + 2], oa0[4 * gq + 3]); *(u32x2*)(oab + 8 * gq + 4 * h) = w0;
        u32x2 w1; w1.x = pk2(oa1[4 * gq], oa1[4 * gq + 1]); w1.y = pk2(oa1[4 * gq + 2], oa1[4 * gq + 3]); *(u32x2*)(oab + 32 + 8 * gq + 4 * h) = w1;
    }
    __syncthreads();
}

#define XB_TMO      128
#define XB_XCNT(j)  (256  + 64 * (j))
#define XB_XSUB(j)  (1280 + 64 * (j))
#define XB_XGEN(j)  (2304 + 64 * (j))
#define XB_TOP      3328
#define XB_TOPGEN   3392
#define XCD_BAR_WORDS 3456
#define XB_SPIN_CAP (1u << 18)
DI unsigned xb_ld(unsigned* p)              { return __hip_atomic_load(p, __ATOMIC_RELAXED, __HIP_MEMORY_SCOPE_AGENT); }
DI unsigned xb_add(unsigned* p, unsigned v) { return __hip_atomic_fetch_add(p, v, __ATOMIC_RELAXED, __HIP_MEMORY_SCOPE_AGENT); }
DI unsigned xb_xcc_id() { return (unsigned)__builtin_amdgcn_s_getreg((3 << 11) | 20) & 0xFu; }
#define XB_SPIN(cond, bar) do { unsigned _sp = 0; while (cond) { __builtin_amdgcn_s_sleep(1); \
    if ((++_sp & 255u) == 0u) { if (xb_ld(&(bar)[XB_TMO])) break; if (_sp > XB_SPIN_CAP) { atomicAdd(&(bar)[XB_TMO], 1u); break; } } } } while (0)
struct XcdBarrier { unsigned* bar; unsigned x; volatile LAS unsigned* st; };
DI void xcd_barrier_complete(unsigned* bar, unsigned x, unsigned& nloc, unsigned& nx) {
    const unsigned G = gridDim.x * gridDim.y * gridDim.z;
    unsigned sum, cnt, mine, sp = 0u;
    for (;;) {
        sum = 0u; cnt = 0u; mine = 0u;
#pragma unroll
        for (unsigned j = 0; j < 16; ++j) { const unsigned c = xb_ld(&bar[XB_XCNT(j)]); sum += c; cnt += (c > 0u) ? 1u : 0u; mine = (j == x) ? c : mine; }
        if (sum == G) break;
        __builtin_amdgcn_s_sleep(1);
        if ((++sp & 255u) == 0u) { if (xb_ld(&bar[XB_TMO])) break; if (sp > XB_SPIN_CAP) { atomicAdd(&bar[XB_TMO], 1u); break; } }
    }
    nloc = mine > 0u ? mine : 1u; nx = cnt > 0u ? cnt : 1u;
}
__device__ __attribute__((noinline)) void xcd_barrier(unsigned* bar, volatile LAS unsigned* st) {
    asm volatile("s_waitcnt vmcnt(0)" ::: "memory");
    __syncthreads();
    if (threadIdx.x == 0) {
        const unsigned x = xb_xcc_id();
        __builtin_amdgcn_s_waitcnt(0);
        unsigned nloc = st[0], nx = st[1];
        if (nloc == 0u) { xcd_barrier_complete(bar, x, nloc, nx); st[0] = nloc; st[1] = nx; }
        const unsigned old = xb_add(&bar[XB_XSUB(x)], 1u);
        const unsigned gen = old / nloc;
        if (old + 1u == (gen + 1u) * nloc) {
            __builtin_amdgcn_fence(__ATOMIC_RELEASE, "agent");
            asm volatile("s_waitcnt vmcnt(0)" ::: "memory");
            const unsigned og = xb_add(&bar[XB_TOP], 1u);
            const unsigned tg = og / nx;
            if (og + 1u == (tg + 1u) * nx) xb_add(&bar[XB_TOPGEN], 1u);
            else XB_SPIN(xb_ld(&bar[XB_TOPGEN]) == tg, bar);
            __builtin_amdgcn_fence(__ATOMIC_ACQUIRE, "agent");
            xb_add(&bar[XB_XGEN(x)], 1u);
            asm volatile("s_waitcnt vmcnt(0)" ::: "memory");
        } else {
            XB_SPIN(xb_ld(&bar[XB_XGEN(x)]) == gen, bar);
            __builtin_amdgcn_fence(__ATOMIC_ACQUIRE, "agent");
            asm volatile("s_waitcnt vmcnt(0)" ::: "memory");
        }
    }
    __syncthreads();
}

DI void ph1(const Params& P, LAS unsigned char* lds, int G, int bid) {
    unsigned char* ws = P.ws;
    pg8::Gemm g{(const bf16_t*)(ws + WS_H1), (const bf16_t*)(ws + WS_WIN), T_, NIN, 1024, 1024, 128}; pg8::StaticOrder S; S.init(T_, NIN, G, bid);
    pg8::EpiProj E{ws}; pg8::gemm_phase(lds, g, S, E);
}
DI void ph2(const Params& P, LAS unsigned char* lds, int G, int bid) {
    if (G == 256) {
        const int x = bid & 7, k = bid >> 3;
        if (k < 16) { cmp_unit(P, lds, bid);
            for (int j = 0; j < 2; ++j) { const int v = (8 + (x >> 1)) * 64 + (x & 1) * 32 + k * 2 + j; dil_unit(P, lds, v / 192, (v / 64) % 3, v % 64); } }
        else for (int j = 0; j < 4; ++j) { const int v = x * 64 + (k - 16) * 4 + j; dil_unit(P, lds, v / 192, (v / 64) % 3, v % 64); }
    } else
    for (int u = bid; u < 128 + 768; u += G) {
        if (u < 128) cmp_unit(P, lds, u);
        else { const int v = u - 128; dil_unit(P, lds, v / 192, (v / 64) % 3, v % 64); }
    }
    __syncthreads();
}
DI void ph3(const Params& P, LAS unsigned char* lds, int G, int bid) {
    unsigned char* ws = P.ws; const int tid = threadIdx.x;
    for (int p0 = bid; p0 < 256; p0 += G) { const int p = (G == 256) ? ((p0 & 7) * 32 + (p0 >> 3)) : p0;
        const int b = p >> 6, g = (p >> 5) & 1, ip = p & 31;
        nsa_unit(P, lds, b, g, 63 - ip); nsa_unit(P, lds, b, g, ip);
        if (DUP_PHASE == 33) { nsa_unit(P, lds, b, g, 63 - ip); nsa_unit(P, lds, b, g, ip); } }
    const bf16_t* OD = (const bf16_t*)(ws + WS_OD); const float* LSE = (const float*)(ws + WS_LSE); bf16_t* oab = (bf16_t*)P.out;
    for (int it = bid * 512 + tid; it < T_ * 32; it += G * 512) { const int t = it >> 5, hh = (it >> 3) & 3, dc = it & 7;
        const float l0 = LSE[(size_t)t * 4 + hh], l1 = LSE[((size_t)T_ + t) * 4 + hh], l2 = LSE[((size_t)2 * T_ + t) * 4 + hh];
        const float mx = fmaxf(l0, fmaxf(l1, l2)); const float e0 = __expf(l0 - mx), e1 = __expf(l1 - mx), e2 = __expf(l2 - mx); const float inv = 1.0f / (e0 + e1 + e2);
        f32x4 a0, a1, b0, b1, c0, c1; pg8::load8(OD + (size_t)t * 256 + hh * 64 + dc * 8, a0, a1); pg8::load8(OD + ((size_t)T_ + t) * 256 + hh * 64 + dc * 8, b0, b1);
        pg8::load8(OD + ((size_t)2 * T_ + t) * 256 + hh * 64 + dc * 8, c0, c1);
        const float w0 = e0 * inv, w1 = e1 * inv, w2 = e2 * inv;
        pg8::store8(oab + (size_t)t * 768 + 512 + hh * 64 + dc * 8, a0 * w0 + b0 * w1 + c0 * w2, a1 * w0 + b1 * w1 + c1 * w2); }
}
DI void ph4(const Params& P, LAS unsigned char* lds, int G, int bid) {
    unsigned char* ws = P.ws;
    pg8::Gemm g{(const bf16_t*)P.out, (const bf16_t*)(ws + WS_WPN), T_, 1024, 768, 768, 128}; pg8::StaticOrder S; S.init(T_, 1024, G, bid);
    pg8::EpiMerge E{(const bf16_t*)(ws + WS_PJM), (bf16_t*)(ws + WS_MIX)}; pg8::gemm_phase<pg8::EpiMerge, 6>(lds, g, S, E);
}
DI void ph5(const Params& P, LAS unsigned char* lds, int G, int bid) {
    unsigned char* ws = P.ws;
    pg8::Gemm g{(const bf16_t*)(ws + WS_MIX), (const bf16_t*)(ws + WS_WOUT), T_, 1024, 1024, 1024, 128}; pg8::StaticOrder S; S.init(T_, 1024, G, bid);
    pg8::EpiResid<1> E{P.x, P.out, (bf16_t*)(ws + WS_A2), P.g_ffn, (float*)(ws + WS_SSQ2)}; pg8::gemm_phase(lds, g, S, E);
}
DI void ph6(const Params& P, LAS unsigned char* lds, int G, int bid) {
    unsigned char* ws = P.ws;
    pg8::Gemm g{(const bf16_t*)(ws + WS_A2), (const bf16_t*)(ws + WS_WUP), T_, NUP, 1024, 1024, 128}; pg8::StaticOrder S; S.init(T_, NUP, G, bid);
    { LAS float* rsall = (LAS float*)(lds + HIDB_OFF + 8192); const float* ssq = (const float*)(ws + WS_SSQ2); pg8::Unit u;
      for (int i = 0; i < 6 && S.next(i, u); ++i) { const int t = threadIdx.x;
          if (t < 256) { const f32x4* sp = (const f32x4*)(ssq + (size_t)(u.pm * 256 + t) * 16); const f32x4 st = (sp[0] + sp[1]) + (sp[2] + sp[3]);
              rsall[i * 256 + t] = __builtin_amdgcn_rsqf(((st[0] + st[1]) + (st[2] + st[3])) * (1.0f / 1024.0f) + RMS_EPS); } }
      __syncthreads(); }
    pg8::EpiUpConv E{(const float*)(ws + WS_SSQ2), (bf16_t*)(ws + WS_ACT), P.conv_w, P.conv_b, (float*)(ws + WS_ULAST), (float*)(ws + WS_UFIRST), (float*)(ws + WS_GFIRST), lds + HIDB_OFF};
    if (DUP_PHASE == 60) { pg8::EpiNull E0; pg8::gemm_phase(lds, g, S, E0); }
    pg8::gemm_phase(lds, g, S, E);
}
DI void ph8(const Params& P, LAS unsigned char* lds, int G, int bid) {
    unsigned char* ws = P.ws; const int tid = threadIdx.x;
    pg8::StaticOrder S; S.init(T_, 1024, G, bid);
    { const float* ulast = (const float*)(ws + WS_ULAST); const float* ufirst = (const float*)(ws + WS_UFIRST); const float* gfirst = (const float*)(ws + WS_GFIRST); bf16_t* act = (bf16_t*)(ws + WS_ACT);
      pg8::Unit u;
      for (int i = 0; S.next(i, u); ++i) { const int pm = u.pm; const bool first = (pm & 15) == 0;
          for (int c = tid; c < DFF; c += 512) {
              const float ul0 = first ? 0.f : ulast[((size_t)(pm - 1) * 2 + 0) * DFF + c], ul1 = first ? 0.f : ulast[((size_t)(pm - 1) * 2 + 1) * DFF + c];
              const float u0 = ufirst[((size_t)pm * 2 + 0) * DFF + c], u1 = ufirst[((size_t)pm * 2 + 1) * DFF + c];
              const float g0 = gfirst[((size_t)pm * 2 + 0) * DFF + c], g1 = gfirst[((size_t)pm * 2 + 1) * DFF + c];
              const float w0 = P.conv_w[c], w1 = P.conv_w[DFF + c], w2 = P.conv_w[2 * DFF + c], cb = P.conv_b[c];
              const float a0 = gelu_tanh(cb + w0 * ul0 + w1 * ul1 + w2 * u0) * g0, a1 = gelu_tanh(cb + w0 * ul1 + w1 * u0 + w2 * u1) * g1;
              act[(size_t)(pm * 256) * DFF + c] = (bf16_t)(pk2(a0, 0.f) & 0xffffu); act[(size_t)(pm * 256 + 1) * DFF + c] = (bf16_t)(pk2(a1, 0.f) & 0xffffu); } }
      asm volatile("s_waitcnt vmcnt(0)" ::: "memory"); __syncthreads(); }
    pg8::Gemm g{(const bf16_t*)(ws + WS_ACT), (const bf16_t*)(ws + WS_WDN), T_, 1024, DFF, DFF, 128};
    if (DUP_PHASE == 8) { pg8::EpiNull E0; pg8::gemm_phase(lds, g, S, E0); }
    if (G == 256) { pg8::EpiFinal E{P.out, P.out, P.g_final, (float*)(ws + WS_SSQ3), (unsigned*)(ws + WS_CTL) + 3520, lds + HIDB_OFF}; pg8::gemm_phase(lds, g, S, E); }
    else { pg8::EpiResid<0> E{P.out, P.out, nullptr, nullptr, (float*)(ws + WS_SSQ3)}; pg8::gemm_phase(lds, g, S, E); }
}
DI void ph9(const Params& P, LAS unsigned char* lds, int G, int bid) {
    unsigned char* ws = P.ws; const int tid = threadIdx.x;
    const int lane = tid & 63, gw = bid * 8 + (tid >> 6), NGW = G * 8; const float* ssq = (const float*)(ws + WS_SSQ3);
    f32x4 gv[4];
#pragma unroll
    for (int j = 0; j < 4; ++j) gv[j] = ((const f32x4*)P.g_final)[lane + 64 * j];
    for (int m = gw; m < T_; m += NGW) {
        const f32x4* sp = (const f32x4*)(ssq + (size_t)m * 16); const f32x4 st = (sp[0] + sp[1]) + (sp[2] + sp[3]);
        const float rstd = 1.0f / sqrtf(((st[0] + st[1]) + (st[2] + st[3])) * (1.0f / 1024.0f) + RMS_EPS);
        f32x4* xr = (f32x4*)(P.out + (size_t)m * D_) + lane;
#pragma unroll
        for (int j = 0; j < 4; ++j) xr[64 * j] = xr[64 * j] * rstd * gv[j];
    }
}

__device__ __attribute__((noinline)) void grid_sync_call() { cg::this_grid().sync(); }
__global__ void __launch_bounds__(512, 2) fwd_megakernel(Params P) {
    extern __shared__ __attribute__((aligned(16))) unsigned char lds_raw[];
    LAS unsigned char* lds = (LAS unsigned char*)lds_raw;
    const int G = gridDim.x, bid = blockIdx.x;
    const int lo = P.ph_lo, hi = P.ph_hi;
    unsigned* barw = (unsigned*)(P.ws + WS_CTL); volatile LAS unsigned* stw = (volatile LAS unsigned*)(lds + ST_OFF);
    if (threadIdx.x < 4) stw[threadIdx.x] = 0u;
    if (threadIdx.x == 0) (void)xb_add(&barw[XB_XCNT(xb_xcc_id())], 1u);
    if (lo < 0) grid_sync_call();
    __syncthreads();
#define IN(k) (lo <= (k) && (k) < hi)
#define SEAM(k) do { if (IN(k) && hi > (k) + 1) xcd_barrier(barw, stw); } while (0)
#ifndef PROBE_SPAN
#define PROBE_SPAN -1
#endif
#define TS0(k) do { if (PROBE_SPAN == (k) && bid == 0 && threadIdx.x == 0) stw[2] = (unsigned)__builtin_amdgcn_s_memrealtime(); } while (0)
#define TS1(k) do { if (PROBE_SPAN == (k) && bid == 0 && threadIdx.x == 0) stw[3] = (unsigned)__builtin_amdgcn_s_memrealtime(); } while (0)
#define PHASE(k, fn) do { TS0(k); if (IN(k)) { fn(P, lds, G, bid); if (DUP_PHASE == (k)) fn(P, lds, G, bid); } SEAM(k); TS1(k); } while (0)
    TS0(0);
    if (IN(0)) { p0_prologue(P, lds); __syncthreads(); if (DUP_PHASE == 0) { p0_prologue(P, lds); __syncthreads(); } }
    SEAM(0); TS1(0);
    PHASE(1, ph1); PHASE(2, ph2); PHASE(3, ph3); PHASE(4, ph4); PHASE(5, ph5); PHASE(6, ph6);
    TS0(8);
    if (IN(8)) ph8(P, lds, G, bid);
    if (G != 256) { SEAM(8); } TS1(8);
    TS0(9);
    if (IN(9) && G != 256) ph9(P, lds, G, bid);
    TS1(9);
    if (PROBE_SPAN >= 0 && bid == 0 && threadIdx.x == 0) { const unsigned t = (unsigned)__builtin_amdgcn_s_memrealtime(), d = stw[3] - stw[2]; while ((unsigned)__builtin_amdgcn_s_memrealtime() - t < d) __builtin_amdgcn_s_sleep(8); }
#undef TS0
#undef TS1
#undef IN
#undef SEAM
#undef PHASE
}

extern "C" void kernel_launch(void* const* d_in, const int* in_sizes, int n_in, void* d_out, int out_size, void* d_ws, size_t ws_size, hipStream_t stream) {
    static int grid = 0;
    if (grid == 0) {
        if (n_in != 18 || ws_size < WS_END) { fprintf(stderr, "kernel_launch: unexpected inputs (n_in %d, ws %zu)\n", n_in, ws_size); grid = -1; return; }
        int dev = 0, cus = 0, per_cu = 0;
        (void)hipGetDevice(&dev); (void)hipDeviceGetAttribute(&cus, hipDeviceAttributeMultiprocessorCount, dev);
        if (hipFuncSetAttribute((const void*)fwd_megakernel, hipFuncAttributeMaxDynamicSharedMemorySize, LDS_BYTES) != hipSuccess) { fprintf(stderr, "hipFuncSetAttribute failed\n"); grid = -1; return; }
        if (hipOccupancyMaxActiveBlocksPerMultiprocessor(&per_cu, (const void*)fwd_megakernel, 512, LDS_BYTES) != hipSuccess || per_cu < 1) per_cu = 1;
        (void)hipGetLastError();
        grid = cus * per_cu;
    }
    if (grid < 0) return;
    if (hipMemsetAsync((char*)d_ws + WS_CTL, 0, CTL_BYTES, stream) != hipSuccess) { fprintf(stderr, "memset failed\n"); return; }
    Params p{};
    const float** f = (const float**)&p;
    for (int i = 0; i < 18; ++i) f[i] = (const float*)d_in[i];
    p.out = (float*)d_out; p.ws = (unsigned char*)d_ws; p.ph_lo = 0; p.ph_hi = 10;
    void* args[] = {&p};
    hipError_t e = hipLaunchCooperativeKernel((const void*)fwd_megakernel, dim3(grid), dim3(512), args, LDS_BYTES, stream);
    if (e != hipSuccess) fprintf(stderr, "cooperative launch failed: %s (grid %d)\n", hipGetErrorString(e), grid);
}
```

```cpp
#include <hip/hip_runtime.h>
#include <hip/hip_cooperative_groups.h>
#include <cstdio>
#include <cstdint>
namespace cg = cooperative_groups;

#define LAS __attribute__((address_space(3)))
#define DI __device__ __forceinline__
typedef unsigned short bf16_t;
typedef short bf16x8 __attribute__((ext_vector_type(8)));
typedef short s16x4 __attribute__((ext_vector_type(4)));
typedef float f32x4 __attribute__((ext_vector_type(4)));
typedef float f32x2 __attribute__((ext_vector_type(2)));
typedef float f32x16 __attribute__((ext_vector_type(16)));
typedef unsigned u32x4 __attribute__((ext_vector_type(4)));
typedef unsigned u32x2 __attribute__((ext_vector_type(2)));
typedef __bf16 bf16x2v __attribute__((ext_vector_type(2)));

constexpr int B_ = 4, S_ = 4096, D_ = 1024, T_ = B_ * S_;
constexpr int NIN = 5888;
constexpr int NINSRC = 5656;
constexpr int DFF = 2816, NUP = 5632;
constexpr float RMS_EPS = 1e-6f;
constexpr float LOG2E = 1.4426950408889634f, LN2 = 0.6931471805599453f;

constexpr size_t MiB = 1u << 20;
constexpr size_t WS_WIN = 0;
constexpr size_t WS_WUP = WS_WIN + (size_t)NIN * 1024 * 2;
constexpr size_t WS_WDN = WS_WUP + (size_t)NUP * 1024 * 2;
constexpr size_t WS_WOUT = WS_WDN + (size_t)1024 * DFF * 2;
constexpr size_t WS_WPN = WS_WOUT + (size_t)1024 * 1024 * 2;
constexpr size_t WS_WPD = WS_WPN + (size_t)1024 * 512 * 2;
constexpr size_t WS_W1K = WS_WPD + (size_t)1024 * 256 * 2;
constexpr size_t WS_W1V = WS_W1K + (size_t)128 * 2048 * 2;
constexpr size_t WS_W2K = WS_W1V + (size_t)128 * 2048 * 2;
constexpr size_t WS_W2V = WS_W2K + (size_t)64 * 128 * 2;
constexpr size_t WS_WEND = WS_W2V + (size_t)64 * 128 * 2;
constexpr size_t WS_R1 = 33 * MiB;
constexpr size_t WS_PJQ = WS_R1, WS_PJKV = WS_R1 + 16 * MiB, WS_PJB = WS_R1 + 40 * MiB, WS_PJM = WS_R1 + 112 * MiB, WS_PJG = WS_R1 + 176 * MiB;
constexpr size_t WS_MIX = WS_R1;
constexpr size_t WS_UG = WS_R1;
constexpr size_t WS_R2 = 217 * MiB;
constexpr size_t WS_H1 = WS_R2, WS_OD = WS_R2, WS_LSE = WS_R2 + 24 * MiB, WS_A2 = WS_R2;
constexpr size_t WS_KC = 249 * MiB, WS_VC = WS_KC + 262144, WS_CTL = WS_KC + 524288, CTL_BYTES = 16384, WS_SSQ2 = 250 * MiB, WS_SSQ3 = 250 * MiB;
constexpr size_t SIDE_BYTES = (size_t)64 * 2 * DFF * 4, WS_ULAST = 251 * MiB, WS_UFIRST = WS_ULAST + SIDE_BYTES, WS_GFIRST = WS_UFIRST + SIDE_BYTES, WS_END = WS_GFIRST + SIDE_BYTES;
constexpr size_t WS_ACT = WS_R1;
static_assert(WS_END <= 256 * MiB, "ws");
static_assert(WS_WEND <= WS_R1, "weights");

constexpr int LDS_BYTES = 147456;
constexpr int KT_STRIDE = 144, VT_STRIDE = 136, VT_OFF = 64 * KT_STRIDE, KV_REGION = VT_OFF + 64 * VT_STRIDE;
constexpr int IMP_OFF = 73728, IMP_QS = 65, IMP_BYTES = 4 * 64 * IMP_QS * 4;
constexpr int SEL_OFF = IMP_OFF + IMP_BYTES, UNI_OFF = SEL_OFF + 512;
static_assert(UNI_OFF + 64 <= LDS_BYTES, "lds");
constexpr int HIDB_OFF = 131072, HIDB_STRIDE = 272;
constexpr int MXT_OFF = 36864, SPL_OFF = 40960;
static_assert(2 * KV_REGION <= MXT_OFF && SPL_OFF + 4096 <= IMP_OFF, "lds nsa");
constexpr int ST_OFF = LDS_BYTES - 16;

struct Params {
    const float *x, *g_mix, *w_in, *pe_k, *w_k1, *w_k2, *pe_v, *w_v1, *w_v2, *w_pn, *w_pd, *w_out, *g_ffn, *w_up, *conv_w, *conv_b, *w_down, *g_final;
    float* out; unsigned char* ws; int ph_lo, ph_hi;
};

DI float bf2f(unsigned v) { return __builtin_bit_cast(float, v << 16); }
DI unsigned pk2(float a, float b) { f32x2 v = {a, b}; return __builtin_bit_cast(unsigned, __builtin_convertvector(v, bf16x2v)); }
DI float wave_sum(float v) {
#pragma unroll
    for (int o = 1; o < 64; o <<= 1) v += __shfl_xor(v, o, 64);
    return v;
}
DI float fexp2(float x) { return __builtin_amdgcn_exp2f(x); }
DI float sigmoidf_(float x) { return __builtin_amdgcn_rcpf(1.0f + fexp2(-LOG2E * x)); }
DI float gelu_tanh(float x) {
    const float t = x * x;
    const float u = __builtin_fmaf(t, -2.0f * LOG2E * 0.7978845608028654f * 0.044715f, -2.0f * LOG2E * 0.7978845608028654f);
    const float e = fexp2(x * u);
    return x * __builtin_amdgcn_rcpf(1.0f + e);
}
DI int crow(int i, int h) { return (i & 3) + 8 * (i >> 2) + 4 * h; }
#define MFMA32(a, b, c) __builtin_amdgcn_mfma_f32_32x32x16_bf16((a), (b), (c), 0, 0, 0)

namespace pg8 {
constexpr int BM = 256, BK = 64, HALF = 128, HTB = HALF * BK * 2, NXCD = 8, WGM = 4;
DI int lds_byte(int r, int c) { const int st = (r >> 4) * 2 + (c >> 5), rr = r & 15, cc = c & 31, ob = rr * 64 + cc * 2; return st * 1024 + (ob ^ (((ob >> 9) & 1) << 5)); }
DI void stage_rc(int b, int& R, int& C) { const int st = b / 1024, sb = b % 1024, swz = sb ^ (((sb >> 9) & 1) << 5); R = (st >> 1) * 16 + swz / 64; C = (st & 1) * 32 + (swz % 64) / 2; }
DI int perm32(int rho) { const int n = rho >> 4, i = rho & 15; return 8 * (i >> 2) + 4 * n + (i & 3); }
struct Unit { int pm, pn, idx; };
struct Gemm { const bf16_t* A; const bf16_t* Bt; int M, N, K, lda, apair; };
struct StaticOrder {
    int nM, nN, nwg, G, c;
    DI void init(int M, int N, int G_, int c_) { nM = M / BM; nN = N / BM; nwg = nM * nN; G = G_; c = c_; }
    DI bool next(int i, Unit& u) const {
        const long L = (long)i * G + c; if (L >= nwg) return false;
        int wgid = (int)L; { const int q = nwg / NXCD, r = nwg % NXCD, xcd = wgid % NXCD, off = wgid / NXCD; wgid = (xcd < r ? xcd * (q + 1) : r * (q + 1) + (xcd - r) * q) + off; }
        const int nig = WGM * nN, gid = wgid / nig, fm = gid * WGM, gsz = (nM - fm) < WGM ? (nM - fm) : WGM;
        u.pm = fm + ((wgid % nig) % gsz); u.pn = (wgid % nig) / gsz; u.idx = i; return true;
    }
};
template <class Epi, int HOOK_T = -1>
DI void gemm_phase(LAS unsigned char* lds, const Gemm g, const StaticOrder& S, const Epi& E) {
    const int tid = threadIdx.x, wid = __builtin_amdgcn_readfirstlane(tid >> 6), lane = tid & 63, wr = wid >> 2, wc = wid & 3, fr = lane & 15, fq = lane >> 4;
    const int K = g.K, nt = K / BK, lda = g.lda;
    unsigned voffA[2], voffB[2];
#pragma unroll
    for (int i = 0; i < 2; ++i) { int R, C; stage_rc(tid * 16 + i * 8192, R, C); const int Rb = (R & ~31) + perm32(R & 31);
        voffA[i] = (unsigned)(R * lda + C) * 2u; voffB[i] = (unsigned)(Rb * K + C) * 2u; }
    const size_t kstep = (size_t)(BK * 2);
    const size_t apairB = (size_t)g.apair * 2;
    const size_t hstepA = (size_t)HALF * lda * 2, tstepA = 2 * hstepA;
    const size_t hstepB = (size_t)HALF * K * 2, tstepB = 2 * hstepB;
    const unsigned ldsw = (unsigned)wid * 1024u;
    const int aoff = lds_byte(wr * 64 + fr, fq * 8), boff = lds_byte(wc * 32 + fr, fq * 8);
#define PG8_SA(b, h) (((b) * 2 + (h)) * HTB)
#define PG8_SB(b, h) ((4 + (b) * 2 + (h)) * HTB)
#define PG8_STAGE(bufoff, gbase, voff) do { _Pragma("unroll") for (int _i = 0; _i < 2; ++_i) \
        __builtin_amdgcn_global_load_lds((const unsigned*)((const char*)(gbase) + (voff)[_i]), (LAS unsigned*)(lds + (bufoff) + ldsw + _i * 8192), 16, 0, 0); } while (0)
#define PG8_LDA(dst, b, h) do { _Pragma("unroll") for (int m = 0; m < 4; ++m) _Pragma("unroll") for (int k = 0; k < 2; ++k) dst[m][k] = *(const LAS bf16x8*)(lds + PG8_SA(b, h) + aoff + m * 2048 + k * 1024); } while (0)
#define PG8_LDB(dst, b, h) do { _Pragma("unroll") for (int n = 0; n < 2; ++n) _Pragma("unroll") for (int k = 0; k < 2; ++k) dst[n][k] = *(const LAS bf16x8*)(lds + PG8_SB(b, h) + boff + n * 2048 + k * 1024); } while (0)
#define PG8_MMA(ai, bj, At, Bt) do { __builtin_amdgcn_s_setprio(1); _Pragma("unroll") for (int m = 0; m < 4; ++m) _Pragma("unroll") for (int n = 0; n < 2; ++n) _Pragma("unroll") for (int k = 0; k < 2; ++k) \
        acc[ai][bj][m][n] = __builtin_amdgcn_mfma_f32_16x16x32_bf16(Bt[n][k], At[m][k], acc[ai][bj][m][n], 0, 0, 0); __builtin_amdgcn_s_setprio(0); } while (0)
#define PG8_WAIT_V(n) asm volatile("s_waitcnt vmcnt(" #n ")" ::: "memory")
#define PG8_WAIT_L(n) asm volatile("s_waitcnt lgkmcnt(" #n ")" ::: "memory")
#define PG8_BAR __builtin_amdgcn_s_barrier()
#define PG8_SCHED __builtin_amdgcn_sched_barrier(0)
    Unit cur, nxt; int ui = 0;
    if (!S.next(0, cur)) return;
    f32x4 acc[2][2][4][2];
#pragma unroll
    for (int a = 0; a < 2; ++a)
#pragma unroll
        for (int b = 0; b < 2; ++b)
#pragma unroll
            for (int m = 0; m < 4; ++m)
#pragma unroll
                for (int n = 0; n < 2; ++n) acc[a][b][m][n] = (f32x4){0.f, 0.f, 0.f, 0.f};
    bf16x8 At[4][2], B0[2][2], B1[2][2];
    const char* cA = (const char*)g.A + (size_t)cur.pm * tstepA; const char* cB = (const char*)g.Bt + (size_t)cur.pn * tstepB;
    PG8_STAGE(PG8_SB(0, 0), cB, voffB); PG8_STAGE(PG8_SB(0, 1), cB + hstepB, voffB); PG8_STAGE(PG8_SA(0, 0), cA, voffA); PG8_STAGE(PG8_SA(0, 1), cA + hstepA, voffA);
    if (wr == 1) PG8_BAR;
    PG8_WAIT_V(2); PG8_BAR;
    PG8_STAGE(PG8_SB(1, 0), cB + kstep, voffB); PG8_STAGE(PG8_SA(1, 0), cA + kstep, voffA); PG8_STAGE(PG8_SB(1, 1), cB + hstepB + kstep, voffB);
    PG8_WAIT_V(6); PG8_BAR;
    for (;;) {
        const bool has_next = S.next(ui + 1, nxt);
        const char* nA = has_next ? (const char*)g.A + (size_t)nxt.pm * tstepA : cA; const char* nB = has_next ? (const char*)g.Bt + (size_t)nxt.pn * tstepB : cB;
        for (int t = 0; t < nt; t += 2) {
            const bool last = (t == nt - 2);
            const char* a1 = cA + (size_t)(t >> 1) * apairB + kstep;
            const char* a2 = last ? nA : cA + (size_t)((t >> 1) + 1) * apairB; const char* b2 = last ? nB : cB + (size_t)(t + 2) * kstep;
            const char* a3 = a2 + kstep; const char* b3 = b2 + kstep;
            PG8_LDB(B0, 0, 0); PG8_LDB(B1, 0, 1); PG8_SCHED; PG8_LDA(At, 0, 0); PG8_STAGE(PG8_SA(1, 1), a1 + hstepA, voffA);
            PG8_WAIT_V(8); PG8_WAIT_L(0); PG8_BAR; PG8_MMA(0, 0, At, B0); PG8_MMA(0, 1, At, B1); PG8_BAR; PG8_SCHED;
            PG8_LDA(At, 0, 1); PG8_STAGE(PG8_SB(0, 0), b2, voffB); PG8_STAGE(PG8_SB(0, 1), b2 + hstepB, voffB); PG8_STAGE(PG8_SA(0, 0), a2, voffA);
            PG8_WAIT_V(8); PG8_WAIT_L(0); PG8_BAR; PG8_MMA(1, 0, At, B0); PG8_MMA(1, 1, At, B1); PG8_BAR; PG8_SCHED;
            PG8_LDB(B0, 1, 0); PG8_LDB(B1, 1, 1); PG8_SCHED; PG8_LDA(At, 1, 0); PG8_STAGE(PG8_SA(0, 1), a2 + hstepA, voffA);
            PG8_WAIT_V(8); PG8_WAIT_L(0); PG8_BAR; PG8_MMA(0, 0, At, B0); PG8_MMA(0, 1, At, B1); PG8_BAR; PG8_SCHED;
            PG8_LDA(At, 1, 1); PG8_STAGE(PG8_SB(1, 0), b3, voffB); PG8_STAGE(PG8_SB(1, 1), b3 + hstepB, voffB); PG8_STAGE(PG8_SA(1, 0), a3, voffA);
            PG8_WAIT_V(8); PG8_WAIT_L(0); PG8_BAR; PG8_MMA(1, 0, At, B0); PG8_MMA(1, 1, At, B1); PG8_BAR; PG8_SCHED;
            if constexpr (HOOK_T >= 0) { if (t == HOOK_T) { E.hook(acc, cur, wr, wc, fr, fq); PG8_SCHED; } }
        }
        if (wr == 0) PG8_BAR;
        E(acc, cur, wr, wc, fr, fq);
        if (!has_next) break;
#pragma unroll
        for (int a = 0; a < 2; ++a)
#pragma unroll
            for (int b = 0; b < 2; ++b)
#pragma unroll
                for (int m = 0; m < 4; ++m)
#pragma unroll
                    for (int n = 0; n < 2; ++n) acc[a][b][m][n] = (f32x4){0.f, 0.f, 0.f, 0.f};
        cur = nxt; cA = nA; cB = nB; ++ui;
        if (wr == 1) PG8_BAR;
    }
    PG8_WAIT_V(0);
    PG8_BAR;
#undef PG8_SA
#undef PG8_SB
#undef PG8_STAGE
#undef PG8_LDA
#undef PG8_LDB
#undef PG8_MMA
#undef PG8_WAIT_V
#undef PG8_WAIT_L
#undef PG8_BAR
#undef PG8_SCHED
}
typedef f32x4 Acc[2][2][4][2];
DI void store8(bf16_t* p, f32x4 v0, f32x4 v1) { u32x4 w; w.x = pk2(v0[0], v0[1]); w.y = pk2(v0[2], v0[3]); w.z = pk2(v1[0], v1[1]); w.w = pk2(v1[2], v1[3]); *(u32x4*)p = w; }
DI void load8(const bf16_t* p, f32x4& v0, f32x4& v1) { const u32x4 w = *(const u32x4*)p;
    v0 = (f32x4){bf2f(w.x & 0xffffu), bf2f(w.x >> 16), bf2f(w.y & 0xffffu), bf2f(w.y >> 16)}; v1 = (f32x4){bf2f(w.z & 0xffffu), bf2f(w.z >> 16), bf2f(w.w & 0xffffu), bf2f(w.w >> 16)}; }

struct EpiProj {
    unsigned char* ws;
    DI void operator()(Acc& acc, const Unit& u, int wr, int wc, int fr, int fq) const {
        const int pn = u.pn; bf16_t* base; int ld, ct;
        if (pn < 2) { base = (bf16_t*)(ws + WS_PJQ); ld = 512; ct = pn; }
        else if (pn < 5) { base = (bf16_t*)(ws + WS_PJKV); ld = 768; ct = pn - 2; }
        else if (pn < 14) { base = (bf16_t*)(ws + WS_PJB); ld = 2304; ct = pn - 5; }
        else if (pn < 22) { base = (bf16_t*)(ws + WS_PJM); ld = 2048; ct = pn - 14; }
        else { base = (bf16_t*)(ws + WS_PJG); ld = 256; ct = 0; }
        const int row0 = u.pm * BM + wr * 64 + fr, col0 = ct * 256 + wc * 32 + 8 * fq;
#pragma unroll
        for (int ai = 0; ai < 2; ++ai)
#pragma unroll
            for (int m = 0; m < 4; ++m) { bf16_t* rowp = base + (size_t)(row0 + ai * HALF + m * 16) * ld + col0;
#pragma unroll
                for (int bj = 0; bj < 2; ++bj) { f32x4 v0 = acc[ai][bj][m][0], v1 = acc[ai][bj][m][1];
                    if (pn >= 14 && pn < 22) {
#pragma unroll
                        for (int e = 0; e < 4; ++e) { v0[e] = sigmoidf_(v0[e]); v1[e] = sigmoidf_(v1[e]); } }
                    store8(rowp + bj * HALF, v0, v1); } }
    }
};
struct EpiMerge {
    const bf16_t* gate; bf16_t* mix;
    DI void hook(Acc& acc, const Unit& u, int wr, int wc, int fr, int fq) const {
        asm volatile("" : "+v"(fr), "+v"(fq));
        const int row0 = u.pm * BM + wr * 64 + fr, col0 = u.pn * BM + wc * 32 + 8 * fq;
#pragma unroll
        for (int ai = 0; ai < 2; ++ai)
#pragma unroll
            for (int m = 0; m < 4; ++m) { const size_t row = (size_t)(row0 + ai * HALF + m * 16);
#pragma unroll
                for (int bj = 0; bj < 2; ++bj) { const int col = col0 + bj * HALF;
                    f32x4 a0, a1, b0, b1; load8(gate + row * 2048 + col, a0, a1); load8(gate + row * 2048 + 1024 + col, b0, b1);
#pragma unroll
                    for (int e = 0; e < 4; ++e) { acc[ai][bj][m][0][e] *= a0[e] * __builtin_amdgcn_rcpf(b0[e]); acc[ai][bj][m][1][e] *= a1[e] * __builtin_amdgcn_rcpf(b1[e]); } }
                asm volatile("" ::: "memory"); }
    }
    DI void operator()(Acc& acc, const Unit& u, int wr, int wc, int fr, int fq) const {
        const int row0 = u.pm * BM + wr * 64 + fr, col0 = u.pn * BM + wc * 32 + 8 * fq;
#pragma unroll
        for (int ai = 0; ai < 2; ++ai)
#pragma unroll
            for (int m = 0; m < 4; ++m) { const size_t row = (size_t)(row0 + ai * HALF + m * 16);
#pragma unroll
                for (int bj = 0; bj < 2; ++bj) { const int col = col0 + bj * HALF;
                    f32x4 b0, b1; load8(gate + row * 2048 + 1024 + col, b0, b1);
                    store8(mix + row * 1024 + col, acc[ai][bj][m][0] * b0, acc[ai][bj][m][1] * b1); } }
    }
};
template <int WRITE_A2> struct EpiResid {
    const float* xi; float* xo; bf16_t* a2; const float* gw; float* ssq;
    DI void operator()(Acc& acc, const Unit& u, int wr, int wc, int fr, int fq) const {
        const int row0 = u.pm * BM + wr * 64 + fr, col0 = u.pn * BM + wc * 32 + 8 * fq;
#pragma unroll
        for (int ai = 0; ai < 2; ++ai)
#pragma unroll
            for (int m = 0; m < 4; ++m) { const size_t row = (size_t)(row0 + ai * HALF + m * 16); float ss = 0.f;
#pragma unroll
                for (int bj = 0; bj < 2; ++bj) { const int col = col0 + bj * HALF;
                    const f32x4 x0 = *(const f32x4*)(xi + row * 1024 + col), x1 = *(const f32x4*)(xi + row * 1024 + col + 4);
                    const f32x4 v0 = acc[ai][bj][m][0] + x0, v1 = acc[ai][bj][m][1] + x1;
                    *(f32x4*)(xo + row * 1024 + col) = v0; *(f32x4*)(xo + row * 1024 + col + 4) = v1;
                    ss += (v0[0] * v0[0] + v0[1] * v0[1]) + (v0[2] * v0[2] + v0[3] * v0[3]) + (v1[0] * v1[0] + v1[1] * v1[1]) + (v1[2] * v1[2] + v1[3] * v1[3]);
                    if (WRITE_A2) { const f32x4 w0 = *(const f32x4*)(gw + col), w1 = *(const f32x4*)(gw + col + 4); store8(a2 + row * 1024 + col, v0 * w0, v1 * w1); } }
                ss += __shfl_xor(ss, 16, 64); ss += __shfl_xor(ss, 32, 64);
                if (fq == 0) ssq[row * 16 + u.pn * 4 + wc] = ss; }
    }
};
struct EpiFinal {
    const float* xi; float* xo; const float* gw; float* ssq; unsigned* cnt; LAS unsigned char* xlds;
    DI void operator()(Acc& acc, const Unit& u, int wr, int wc, int fr, int fq) const {
        asm volatile("" : "+v"(fr), "+v"(fq));
        const int lane = fr + 16 * fq, t = (wr * 4 + wc) * 64 + lane;
        const int row0 = u.pm * BM + wr * 64 + fr, col0 = u.pn * BM + wc * 32 + 8 * fq;
#pragma unroll
        for (int ai = 0; ai < 2; ++ai)
#pragma unroll
            for (int m = 0; m < 4; ++m) { const size_t row = (size_t)(row0 + ai * HALF + m * 16); float ss = 0.f;
#pragma unroll
                for (int bj = 0; bj < 2; ++bj) { const int col = col0 + bj * HALF;
                    const f32x4 x0 = *(const f32x4*)(xi + row * 1024 + col), x1 = *(const f32x4*)(xi + row * 1024 + col + 4);
                    const f32x4 v0 = acc[ai][bj][m][0] + x0, v1 = acc[ai][bj][m][1] + x1;
                    acc[ai][bj][m][0] = v0; acc[ai][bj][m][1] = v1;
                    ss += (v0[0] * v0[0] + v0[1] * v0[1]) + (v0[2] * v0[2] + v0[3] * v0[3]) + (v1[0] * v1[0] + v1[1] * v1[1]) + (v1[2] * v1[2] + v1[3] * v1[3]); }
                ss += __shfl_xor(ss, 16, 64); ss += __shfl_xor(ss, 32, 64);
                if (fq == 0) ssq[row * 16 + u.pn * 4 + wc] = ss;
                if (m & 1) asm volatile("" ::: "memory"); }
        asm volatile("s_waitcnt vmcnt(0)" ::: "memory");
        __syncthreads();
        if (t == 0) {
            __builtin_amdgcn_fence(__ATOMIC_RELEASE, "agent"); asm volatile("s_waitcnt vmcnt(0)" ::: "memory");
            (void)__hip_atomic_fetch_add(cnt + u.pm, 1u, __ATOMIC_RELAXED, __HIP_MEMORY_SCOPE_AGENT);
            unsigned sp = 0;
            while (__hip_atomic_load(cnt + u.pm, __ATOMIC_RELAXED, __HIP_MEMORY_SCOPE_AGENT) < 4u) { __builtin_amdgcn_s_sleep(1); if (++sp > (1u << 22)) break; }
            __builtin_amdgcn_fence(__ATOMIC_ACQUIRE, "agent"); asm volatile("s_waitcnt vmcnt(0)" ::: "memory");
        }
        __syncthreads();
        LAS float* rs = (LAS float*)xlds;
        if (t < 256) { const f32x4* sp = (const f32x4*)(ssq + (size_t)(u.pm * BM + t) * 16); const f32x4 st = (sp[0] + sp[1]) + (sp[2] + sp[3]);
            rs[t] = 1.0f / sqrtf(((st[0] + st[1]) + (st[2] + st[3])) * (1.0f / 1024.0f) + RMS_EPS); }
        __syncthreads();
#pragma unroll
        for (int ai = 0; ai < 2; ++ai)
#pragma unroll
            for (int m = 0; m < 4; ++m) { const int rl = ai * HALF + wr * 64 + m * 16 + fr; const size_t row = (size_t)(u.pm * BM + rl); const float rstd = rs[rl];
#pragma unroll
                for (int bj = 0; bj < 2; ++bj) { const int col = col0 + bj * HALF;
                    const f32x4 w0 = *(const f32x4*)(gw + col), w1 = *(const f32x4*)(gw + col + 4);
                    *(f32x4*)(xo + row * 1024 + col) = acc[ai][bj][m][0] * rstd * w0; *(f32x4*)(xo + row * 1024 + col + 4) = acc[ai][bj][m][1] * rstd * w1; } }
    }
};
DI void store4(bf16_t* p, f32x4 v) { u32x2 w; w.x = pk2(v[0], v[1]); w.y = pk2(v[2], v[3]); *(u32x2*)p = w; }
struct EpiUpConv {
    const float* ssq; bf16_t* act; const float* conv_w; const float* conv_b; float* ulast; float* ufirst; float* gfirst; LAS unsigned char* xlds;
    DI void operator()(Acc& acc, const Unit& u, int wr, int wc, int fr, int fq) const {
        asm volatile("" : "+v"(fr), "+v"(fq));
        const int lane = fr + 16 * fq;
        const int colg = u.pn * 128 + wc * 32 + 8 * fq;
        LAS float* xs = (LAS float*)xlds;
        const LAS float* rs = (const LAS float*)(xlds + 8192) + u.idx * 256;
#pragma unroll
        for (int ai = 0; ai < 2; ++ai)
#pragma unroll
            for (int m = 0; m < 4; ++m) { const float rstd = rs[ai * HALF + wr * 64 + m * 16 + fr];
#pragma unroll
                for (int bj = 0; bj < 2; ++bj)
#pragma unroll
                    for (int n = 0; n < 2; ++n) acc[ai][bj][m][n] *= rstd; }
        if (fr >= 14) {
#pragma unroll
            for (int ai = 0; ai < 2; ++ai) { LAS float* slot = xs + ((((ai * 2 + wr) * 4 + wc) * 2 + (fr - 14)) * 4 + fq) * 8;
                *(LAS f32x4*)slot = acc[ai][0][3][0]; *(LAS f32x4*)(slot + 4) = acc[ai][0][3][1]; }
            if (wr == 1) { float* p = ulast + ((size_t)u.pm * 2 + (fr - 14)) * DFF + colg; *(f32x4*)p = acc[1][0][3][0]; *(f32x4*)(p + 4) = acc[1][0][3][1]; }
        }
        if (fr < 2 && wr == 0) { float* p = ufirst + ((size_t)u.pm * 2 + fr) * DFF + colg; *(f32x4*)p = acc[0][0][0][0]; *(f32x4*)(p + 4) = acc[0][0][0][1];
            float* q = gfirst + ((size_t)u.pm * 2 + fr) * DFF + colg; *(f32x4*)q = acc[0][1][0][0]; *(f32x4*)(q + 4) = acc[0][1][0][1]; }
        __syncthreads();
#pragma unroll
        for (int n = 0; n < 2; ++n) {
            const f32x4 w0 = *(const f32x4*)(conv_w + colg + 4 * n), w1 = *(const f32x4*)(conv_w + DFF + colg + 4 * n), w2 = *(const f32x4*)(conv_w + 2 * DFF + colg + 4 * n), cb = *(const f32x4*)(conv_b + colg + 4 * n);
#pragma unroll
            for (int ai = 0; ai < 2; ++ai) {
                f32x4 r1p = {0.f, 0.f, 0.f, 0.f}, r2p = r1p;
                if (ai == 1 || wr == 1) { const int pai = wr ? ai : ai - 1, pwr = wr ? 0 : 1;
                    const f32x4 p1 = *(const LAS f32x4*)(xs + ((((pai * 2 + pwr) * 4 + wc) * 2 + 1) * 4 + fq) * 8 + 4 * n), p2 = *(const LAS f32x4*)(xs + ((((pai * 2 + pwr) * 4 + wc) * 2 + 0) * 4 + fq) * 8 + 4 * n);
                    r1p = p1; r2p = fr == 0 ? p2 : p1; }
#pragma unroll
                for (int m = 0; m < 4; ++m) {
                    const f32x4 ua = acc[ai][0][m][n];
                    f32x4 r1, r2;
#pragma unroll
                    for (int e = 0; e < 4; ++e) { r1[e] = __int_as_float(__builtin_amdgcn_update_dpp(0, __float_as_int(ua[e]), 0x121, 0xf, 0xf, false));
                        r2[e] = __int_as_float(__builtin_amdgcn_update_dpp(0, __float_as_int(ua[e]), 0x122, 0xf, 0xf, false)); }
                    const f32x4 pv1 = fr >= 1 ? r1 : r1p, pv2 = fr >= 2 ? r2 : r2p;
                    f32x4 v = cb + w0 * pv2 + w1 * pv1 + w2 * ua;
                    const f32x4 ga = acc[ai][1][m][n];
#pragma unroll
                    for (int e = 0; e < 4; ++e) v[e] = gelu_tanh(v[e]) * ga[e];
                    const bool skip = (ai == 0 && m == 0 && wr == 0 && fr < 2);
                    if (!skip) store4(act + (size_t)(u.pm * BM + ai * HALF + wr * 64 + m * 16 + fr) * DFF + colg + 4 * n, v);
                    r1p = r1; r2p = r2;
                    asm volatile("" ::: "memory");
                }
            }
        }
    }
};
struct EpiNull { DI void operator()(Acc& acc, const Unit& u, int wr, int wc, int fr, int fq) const { if (acc[0][0][0][0][0] == 1234.5f) *(volatile int*)nullptr = 0; } };
}

#ifndef DUP_PHASE
#define DUP_PHASE -1
#endif
DI int rowmap(int mode, int n) {
    if (mode == 1) { if (n < 1280) return n; if (n < 1304) return 5632 + (n - 1280); return n - 24; }
    if (mode == 2) { if (n < DFF) return (n >> 7) * 256 + (n & 127); const int q = n - DFF; return (q >> 7) * 256 + 128 + (q & 127); }
    return n;
}
DI void transpose_item(const float* W, int K, int N, bf16_t* WT, int ldt, int mode, LAS float* scr, int item, int lane) {
    const int nblk = (N + 31) / 32, kb = item / nblk, nb = item % nblk, k0 = 64 * kb, n0 = 32 * nb;
    const int nl = n0 + (lane & 31);
    float tv[32];
    const float* wp = W + (size_t)(k0 + (lane >> 5)) * N + (nl < N ? nl : 0);
#pragma unroll
    for (int i = 0; i < 32; ++i) tv[i] = wp[(size_t)(2 * i) * N];
#pragma unroll
    for (int i = 0; i < 32; ++i) scr[(2 * i + (lane >> 5)) * 33 + (lane & 31)] = tv[i];
    asm volatile("s_waitcnt lgkmcnt(0)" ::: "memory");
    const int c = lane & 7;
#pragma unroll
    for (int j = 0; j < 4; ++j) { const int n = (lane >> 3) + 8 * j; const LAS float* s = scr + (8 * c) * 33 + n;
        u32x4 o; o.x = pk2(s[0 * 33], s[1 * 33]); o.y = pk2(s[2 * 33], s[3 * 33]); o.z = pk2(s[4 * 33], s[5 * 33]); o.w = pk2(s[6 * 33], s[7 * 33]);
        if (n0 + n < N) *(u32x4*)(WT + (size_t)rowmap(mode, n0 + n) * ldt + k0 + 8 * c) = o; }
    asm volatile("s_waitcnt lgkmcnt(0)" ::: "memory");
}
DI void p0_prologue(const Params& P, LAS unsigned char* lds) {
    const int tid = threadIdx.x, lane = tid & 63, wave = tid >> 6;
    LAS float* scr = (LAS float*)(lds + wave * 16384);
    const int gw = blockIdx.x * 8 + wave, NGW = gridDim.x * 8;
    unsigned char* ws = P.ws;
    int base = 0;
#define DOJOB(W_, K_, N_, OFF_, MODE_, LDT_) do { const int items = ((K_) / 64) * (((N_) + 31) / 32); \
        int first = gw - (base % NGW); if (first < 0) first += NGW; \
        for (int it = first; it < items; it += NGW) transpose_item((W_), (K_), (N_), (bf16_t*)(ws + (OFF_)), (LDT_), (MODE_), scr, it, lane); \
        base += items; } while (0)
    DOJOB(P.w_in, 1024, NINSRC, WS_WIN, 1, 1024); DOJOB(P.w_up, 1024, NUP, WS_WUP, 2, 1024); DOJOB(P.w_down, DFF, 1024, WS_WDN, 0, DFF); DOJOB(P.w_out, 1024, 1024, WS_WOUT, 0, 1024);
    DOJOB(P.w_pn, 512, 1024, WS_WPN, 0, 768); DOJOB(P.w_pd, 256, 1024, WS_WPN + 1024, 0, 768); DOJOB(P.w_k1, 2048, 128, WS_W1K, 0, 2048); DOJOB(P.w_v1, 2048, 128, WS_W1V, 0, 2048);
    DOJOB(P.w_k2, 128, 64, WS_W2K, 0, 128); DOJOB(P.w_v2, 128, 64, WS_W2V, 0, 128);
#undef DOJOB
    { u32x4* z = (u32x4*)(ws + WS_WIN + (size_t)NINSRC * 1024 * 2); const int n16 = (NIN - NINSRC) * 1024 * 2 / 16;
      for (int i = blockIdx.x * 512 + tid; i < n16; i += gridDim.x * 512) z[i] = (u32x4){0u, 0u, 0u, 0u}; }
    bf16_t* H1 = (bf16_t*)(ws + WS_H1);
    f32x4 gv[4];
#pragma unroll
    for (int j = 0; j < 4; ++j) gv[j] = ((const f32x4*)P.g_mix)[lane + 64 * j];
    for (int m0 = gw * 4; m0 < T_; m0 += NGW * 4) {
        f32x4 v[4][4]; float ss[4];
#pragma unroll
        for (int q = 0; q < 4; ++q) { const f32x4* xr = (const f32x4*)(P.x + (size_t)(m0 + q) * D_) + lane;
#pragma unroll
            for (int j = 0; j < 4; ++j) v[q][j] = xr[64 * j]; }
#pragma unroll
        for (int q = 0; q < 4; ++q) { float s = 0.f;
#pragma unroll
            for (int j = 0; j < 4; ++j) s += (v[q][j].x * v[q][j].x + v[q][j].y * v[q][j].y) + (v[q][j].z * v[q][j].z + v[q][j].w * v[q][j].w);
            ss[q] = s; }
#pragma unroll
        for (int o = 1; o < 64; o <<= 1) {
#pragma unroll
            for (int q = 0; q < 4; ++q) ss[q] += __shfl_xor(ss[q], o, 64); }
#pragma unroll
        for (int q = 0; q < 4; ++q) { const float rstd = 1.0f / sqrtf(ss[q] * (1.0f / D_) + RMS_EPS);
            u32x2* o8 = (u32x2*)(H1 + (size_t)(m0 + q) * D_) + lane;
#pragma unroll
            for (int j = 0; j < 4; ++j) { const f32x4 y = v[q][j] * rstd * gv[j]; u32x2 w; w.x = pk2(y.x, y.y); w.y = pk2(y.z, y.w); o8[64 * j] = w; } }
    }
}

struct AttnState { f32x16 o0, o1; float m, l; };
DI void attn_init(AttnState& st) {
#pragma unroll
    for (int i = 0; i < 16; ++i) { st.o0[i] = 0.f; st.o1[i] = 0.f; }
    st.m = -1e29f; st.l = 0.f;
}
DI void stage_kv(LAS unsigned char* kt, const bf16_t* kbase, const bf16_t* vbase, size_t rowstride, int ptid, int nthr, bool with_v) {
    for (int chunk = ptid; chunk < 512; chunk += nthr) {
        const int key = chunk >> 3, dc = chunk & 7;
        const u32x4 kv = *(const u32x4*)(kbase + (size_t)key * rowstride + dc * 8);
        *(LAS u32x4*)(kt + key * KT_STRIDE + dc * 16) = kv;
        if (with_v) {
            const u32x4 vv = *(const u32x4*)(vbase + (size_t)key * rowstride + dc * 8);
            LAS unsigned char* vt = kt + VT_OFF + (dc * 8) * VT_STRIDE + key * 2;
            *(LAS unsigned short*)(vt + 0 * VT_STRIDE) = (unsigned short)(vv.x & 0xffffu); *(LAS unsigned short*)(vt + 1 * VT_STRIDE) = (unsigned short)(vv.x >> 16);
            *(LAS unsigned short*)(vt + 2 * VT_STRIDE) = (unsigned short)(vv.y & 0xffffu); *(LAS unsigned short*)(vt + 3 * VT_STRIDE) = (unsigned short)(vv.y >> 16);
            *(LAS unsigned short*)(vt + 4 * VT_STRIDE) = (unsigned short)(vv.z & 0xffffu); *(LAS unsigned short*)(vt + 5 * VT_STRIDE) = (unsigned short)(vv.z >> 16);
            *(LAS unsigned short*)(vt + 6 * VT_STRIDE) = (unsigned short)(vv.w & 0xffffu); *(LAS unsigned short*)(vt + 7 * VT_STRIDE) = (unsigned short)(vv.w >> 16);
        }
    }
}
template <int NCH> struct KVRegs { u32x4 k[NCH], v[NCH]; };
template <int NCH> DI void kv_load(KVRegs<NCH>& R, const bf16_t* kbase, const bf16_t* vbase, size_t rowstride, int ptid, bool with_v) {
#pragma unroll
    for (int j = 0; j < NCH; ++j) { const int chunk = ptid + j * (512 / NCH), key = chunk >> 3, dc = chunk & 7;
        R.k[j] = *(const u32x4*)(kbase + (size_t)key * rowstride + dc * 8);
        if (with_v) R.v[j] = *(const u32x4*)(vbase + (size_t)key * rowstride + dc * 8); }
}
template <int NCH> DI void kv_store(const KVRegs<NCH>& R, LAS unsigned char* kt, int ptid, bool with_v) {
#pragma unroll
    for (int j = 0; j < NCH; ++j) { const int chunk = ptid + j * (512 / NCH), key = chunk >> 3, dc = chunk & 7;
        *(LAS u32x4*)(kt + key * KT_STRIDE + dc * 16) = R.k[j];
        if (with_v) { const u32x4 vv = R.v[j];
            LAS unsigned char* vt = kt + VT_OFF + (dc * 8) * VT_STRIDE + key * 2;
            *(LAS unsigned short*)(vt + 0 * VT_STRIDE) = (unsigned short)(vv.x & 0xffffu); *(LAS unsigned short*)(vt + 1 * VT_STRIDE) = (unsigned short)(vv.x >> 16);
            *(LAS unsigned short*)(vt + 2 * VT_STRIDE) = (unsigned short)(vv.y & 0xffffu); *(LAS unsigned short*)(vt + 3 * VT_STRIDE) = (unsigned short)(vv.y >> 16);
            *(LAS unsigned short*)(vt + 4 * VT_STRIDE) = (unsigned short)(vv.z & 0xffffu); *(LAS unsigned short*)(vt + 5 * VT_STRIDE) = (unsigned short)(vv.z >> 16);
            *(LAS unsigned short*)(vt + 6 * VT_STRIDE) = (unsigned short)(vv.w & 0xffffu); *(LAS unsigned short*)(vt + 7 * VT_STRIDE) = (unsigned short)(vv.w >> 16); } }
}
template <int NCH, class Body>
DI void run_tiles(LAS unsigned char* buf0, const bf16_t* kb0, const bf16_t* vb0, size_t rowstride, size_t tilestride, unsigned long long mask, int ptid, bool with_v, Body body) {
    if (mask == 0ull) return;
    KVRegs<NCH> R;
    int s = __builtin_ctzll(mask); mask &= mask - 1ull;
    kv_load<NCH>(R, kb0 + (size_t)s * tilestride, vb0 + (size_t)s * tilestride, rowstride, ptid, with_v);
    __syncthreads();
    kv_store<NCH>(R, buf0, ptid, with_v);
    int sn = -1;
    if (mask) { sn = __builtin_ctzll(mask); mask &= mask - 1ull; kv_load<NCH>(R, kb0 + (size_t)sn * tilestride, vb0 + (size_t)sn * tilestride, rowstride, ptid, with_v); }
    __syncthreads();
    int cur = 0;
    for (;;) {
        body(buf0 + cur * KV_REGION, s);
        if (sn < 0) break;
        kv_store<NCH>(R, buf0 + (cur ^ 1) * KV_REGION, ptid, with_v);
        s = sn;
        if (mask) { sn = __builtin_ctzll(mask); mask &= mask - 1ull; kv_load<NCH>(R, kb0 + (size_t)sn * tilestride, vb0 + (size_t)sn * tilestride, rowstride, ptid, with_v); } else sn = -1;
        __syncthreads();
        cur ^= 1;
    }
}
DI void qk_tile(const LAS unsigned char* kt, const bf16x8 (&qf)[4], int r, int h, f32x16& x0, f32x16& x1) {
#pragma unroll
    for (int kk = 0; kk < 4; ++kk) {
        const bf16x8 a0 = *(const LAS bf16x8*)(kt + r * KT_STRIDE + kk * 32 + h * 16);
        const bf16x8 a1 = *(const LAS bf16x8*)(kt + (32 + r) * KT_STRIDE + kk * 32 + h * 16);
        x0 = MFMA32(a0, qf[kk], x0); x1 = MFMA32(a1, qf[kk], x1);
    }
}
DI void bias_init(f32x16& x0, f32x16& x1, float slm, float b0) {
#pragma unroll
    for (int i = 0; i < 16; ++i) { const float c = (float)((i & 3) + 8 * (i >> 2)); x0[i] = __builtin_fmaf(slm, c, b0); x1[i] = __builtin_fmaf(slm, c + 32.0f, b0); }
}
DI bf16x8 pack8(const f32x16& x, int s) {
    u32x4 p; p.x = pk2(x[8 * s + 0], x[8 * s + 1]); p.y = pk2(x[8 * s + 2], x[8 * s + 3]); p.z = pk2(x[8 * s + 4], x[8 * s + 5]); p.w = pk2(x[8 * s + 6], x[8 * s + 7]);
    return __builtin_bit_cast(bf16x8, p);
}
DI bf16x8 scale_q8(bf16x8 q) {
    const u32x4 w = __builtin_bit_cast(u32x4, q); u32x4 o;
    o.x = pk2(bf2f(w.x & 0xffffu) * 0.125f, bf2f(w.x >> 16) * 0.125f); o.y = pk2(bf2f(w.y & 0xffffu) * 0.125f, bf2f(w.y >> 16) * 0.125f);
    o.z = pk2(bf2f(w.z & 0xffffu) * 0.125f, bf2f(w.z >> 16) * 0.125f); o.w = pk2(bf2f(w.w & 0xffffu) * 0.125f, bf2f(w.w >> 16) * 0.125f);
    return __builtin_bit_cast(bf16x8, o);
}
struct NoPost { DI void operator()(const f32x16&, const f32x16&, float) const {} };
template <class VF, class PH = NoPost>
DI void attn_tile_dyn(bool MASKED, const LAS unsigned char* kt, const bf16x8 (&qf)[4], AttnState& st, int r, int h, float slm, float b0, VF valid, PH post = PH()) {
    f32x16 x0, x1;
    bias_init(x0, x1, slm, b0);
    qk_tile(kt, qf, r, h, x0, x1);
    if (MASKED) {
#pragma unroll
        for (int i = 0; i < 16; ++i) { const int k0 = crow(i, h); x0[i] = valid(k0) ? x0[i] : -1e30f; x1[i] = valid(32 + k0) ? x1[i] : -1e30f; }
    }
    float mxa = fmaxf(x0[0], x1[0]), mxb = fmaxf(x0[1], x1[1]);
#pragma unroll
    for (int i = 2; i < 16; i += 2) { mxa = fmaxf(fmaxf(mxa, x0[i]), x1[i]); mxb = fmaxf(fmaxf(mxb, x0[i + 1]), x1[i + 1]); }
    float mx = fmaxf(fmaxf(st.m, mxa), mxb);
    { const unsigned mu = __float_as_uint(mx); const auto sw = __builtin_amdgcn_permlane32_swap(mu, mu, false, false);
      mx = fmaxf(__uint_as_float(sw[0]), __uint_as_float(sw[1])); }
    const float alpha = fexp2((st.m - mx) * LOG2E); st.m = mx;
    const float nm = -mx * LOG2E;
    float ls = 0.f;
#pragma unroll
    for (int i = 0; i < 16; ++i) { x0[i] = fexp2(__builtin_fmaf(x0[i], LOG2E, nm)); x1[i] = fexp2(__builtin_fmaf(x1[i], LOG2E, nm)); ls += x0[i] + x1[i]; }
    st.l = st.l * alpha + ls;
    post(x0, x1, mx);
#pragma unroll
    for (int i = 0; i < 16; ++i) { st.o0[i] *= alpha; st.o1[i] *= alpha; }
    const LAS unsigned char* vt = kt + VT_OFF;
#pragma unroll
    for (int kh = 0; kh < 2; ++kh)
#pragma unroll
        for (int s = 0; s < 2; ++s) {
            const bf16x8 pb = kh ? pack8(x1, s) : pack8(x0, s);
            const int keyoff = (32 * kh + 16 * s + 4 * h) * 2;
            { const LAS unsigned char* vp = vt + r * VT_STRIDE + keyoff; const s16x4 lo = *(const LAS s16x4*)vp, hi = *(const LAS s16x4*)(vp + 16);
              const bf16x8 pa = __builtin_shufflevector(lo, hi, 0, 1, 2, 3, 4, 5, 6, 7); st.o0 = MFMA32(pa, pb, st.o0); }
            { const LAS unsigned char* vp = vt + (32 + r) * VT_STRIDE + keyoff; const s16x4 lo = *(const LAS s16x4*)vp, hi = *(const LAS s16x4*)(vp + 16);
              const bf16x8 pa = __builtin_shufflevector(lo, hi, 0, 1, 2, 3, 4, 5, 6, 7); st.o1 = MFMA32(pa, pb, st.o1); }
        }
}
DI void cmp_unit(const Params& P, LAS unsigned char* lds, int u) {
    int tid = threadIdx.x; asm volatile("" : "+v"(tid));
    const int w = __builtin_amdgcn_readfirstlane(tid >> 6), lane = tid & 63, r = lane & 31, h = lane >> 5;
    const int which = u >> 6, b = (u >> 4) & 3, g = (u >> 3) & 1, ct = u & 7;
    unsigned char* ws = P.ws;
    const bf16_t* src = (const bf16_t*)(ws + WS_PJKV) + which * 128 + g * 64;
    const float* pe = which ? P.pe_v : P.pe_k;
    const bf16_t* W1t = (const bf16_t*)(ws + (which ? WS_W1V : WS_W1K));
    const bf16_t* W2t = (const bf16_t*)(ws + (which ? WS_W2V : WS_W2K));
    bf16_t* outp = (bf16_t*)(ws + (which ? WS_VC : WS_KC));
    const int cbase = 32 * ct; int c = cbase + r; if (c > 254) c = 254;
    f32x16 acc[4];
#pragma unroll
    for (int nt = 0; nt < 4; ++nt)
#pragma unroll
        for (int i = 0; i < 16; ++i) acc[nt][i] = 0.f;
#pragma unroll 1
    for (int jj = 0; jj < 4; ++jj) {
        const int j = 4 * w + jj; const bf16_t* rowp = src + (size_t)(b * S_ + 16 * c + j) * 768;
#pragma unroll
        for (int kk = 0; kk < 4; ++kk) {
            const int d0 = 16 * kk + 8 * h;
            const u32x4 raw = *(const u32x4*)(rowp + d0);
            const f32x4 p0 = *(const f32x4*)(pe + j * 64 + d0), p1 = *(const f32x4*)(pe + j * 64 + d0 + 4);
            u32x4 av; av.x = pk2(bf2f(raw.x & 0xffffu) + p0[0], bf2f(raw.x >> 16) + p0[1]); av.y = pk2(bf2f(raw.y & 0xffffu) + p0[2], bf2f(raw.y >> 16) + p0[3]);
            av.z = pk2(bf2f(raw.z & 0xffffu) + p1[0], bf2f(raw.z >> 16) + p1[1]); av.w = pk2(bf2f(raw.w & 0xffffu) + p1[2], bf2f(raw.w >> 16) + p1[3]);
            const bf16x8 a = __builtin_bit_cast(bf16x8, av);
#pragma unroll
            for (int nt = 0; nt < 4; ++nt) { const bf16x8 bb = *(const bf16x8*)(W1t + (size_t)(32 * nt + r) * 2048 + j * 64 + d0); acc[nt] = MFMA32(a, bb, acc[nt]); }
        }
    }
    __syncthreads();
    LAS float* part = (LAS float*)lds;
#pragma unroll
    for (int nt = 0; nt < 4; ++nt)
#pragma unroll
        for (int i = 0; i < 16; ++i) part[(w * 32 + crow(i, h)) * 128 + 32 * nt + r] = acc[nt][i];
    __syncthreads();
    LAS unsigned char* hidb = lds + HIDB_OFF;
#pragma unroll
    for (int e = 0; e < 8; ++e) { const int o = tid + 512 * e; float s = 0.f;
#pragma unroll
        for (int ww = 0; ww < 8; ++ww) s += part[ww * 4096 + o];
        const float gl = gelu_tanh(s); const int cl = o >> 7, n = o & 127;
        *(LAS unsigned short*)(hidb + cl * HIDB_STRIDE + n * 2) = (unsigned short)(pk2(gl, 0.f) & 0xffffu); }
    __syncthreads();
    if (w < 2) {
        f32x16 a2;
#pragma unroll
        for (int i = 0; i < 16; ++i) a2[i] = 0.f;
#pragma unroll
        for (int ks = 0; ks < 8; ++ks) { const bf16x8 a = *(const LAS bf16x8*)(hidb + r * HIDB_STRIDE + (16 * ks + 8 * h) * 2);
            const bf16x8 bb = *(const bf16x8*)(W2t + (size_t)(32 * w + r) * 128 + 16 * ks + 8 * h); a2 = MFMA32(a, bb, a2); }
#pragma unroll
        for (int i = 0; i < 16; ++i) outp[((size_t)(b * 2 + g) * 256 + cbase + crow(i, h)) * 64 + 32 * w + r] = (bf16_t)(pk2(a2[i], 0.f) & 0xffffu);
    }
    __syncthreads();
}

DI void dil_unit(const Params& P, LAS unsigned char* lds, int b, int g, int u64) {
    int tid = threadIdx.x; asm volatile("" : "+v"(tid));
    const int w = __builtin_amdgcn_readfirstlane(tid >> 6), lane = tid & 63, r = lane & 31, h = lane >> 5;
    const int hh = w >> 1, qh = w & 1;
    const int rd = (g == 0) ? 1 : (g == 1 ? 4 : 16), ntr = 64 / rd, c = u64 / ntr, ut = u64 % ntr;
    const int uq = 64 * ut + 32 * qh + r, tq = c + rd * uq; const size_t trow = (size_t)b * S_ + tq;
    const int head = g * 4 + hh;
    const float slm = fexp2(-(float)(head + 1) * (2.0f / 3.0f)) * (float)rd;
    unsigned char* ws = P.ws;
    const bf16_t* PJB = (const bf16_t*)(ws + WS_PJB);
    bf16x8 qf[4];
#pragma unroll
    for (int kk = 0; kk < 4; ++kk) qf[kk] = scale_q8(*(const bf16x8*)(PJB + trow * 2304 + g * 256 + hh * 64 + 16 * kk + 8 * h));
    AttnState st; attn_init(st);
    const int kt0 = ut >= 2 ? ut - 2 : 0;
    const unsigned long long tmask = ((2ull << ut) - 1ull) & ~((1ull << kt0) - 1ull);
    const bf16_t* kb0 = PJB + ((size_t)b * S_ + c) * 2304 + 768 + g * 256 + hh * 64;
    run_tiles<4>(lds + hh * 2 * KV_REGION, kb0, kb0 + 768, (size_t)rd * 2304, (size_t)rd * 64 * 2304, tmask, tid & 127, true,
        [&](const LAS unsigned char* kt, int t) { const int ubase = uq - 64 * t;
            attn_tile_dyn(t == ut || t + 2 == ut, kt, qf, st, r, h, slm, slm * (float)(4 * h - ubase), [=](int key) { const int du = ubase - key; return du >= 0 && du <= 128; }); });
    const float l = st.l + __shfl_xor(st.l, 32, 64), inv = 1.0f / l;
    bf16_t* od = (bf16_t*)(ws + WS_OD) + ((size_t)g * T_ + trow) * 256 + hh * 64;
#pragma unroll
    for (int gq = 0; gq < 4; ++gq) {
        u32x2 w0; w0.x = pk2(st.o0[4 * gq] * inv, st.o0[4 * gq + 1] * inv); w0.y = pk2(st.o0[4 * gq + 2] * inv, st.o0[4 * gq + 3] * inv);
        *(u32x2*)(od + 8 * gq + 4 * h) = w0;
        u32x2 w1; w1.x = pk2(st.o1[4 * gq] * inv, st.o1[4 * gq + 1] * inv); w1.y = pk2(st.o1[4 * gq + 2] * inv, st.o1[4 * gq + 3] * inv);
        *(u32x2*)(od + 32 + 8 * gq + 4 * h) = w1;
    }
    if (h == 0) ((float*)(ws + WS_LSE))[((size_t)g * T_ + trow) * 4 + hh] = st.m + __log2f(l) * LN2;
}

DI void nsa_unit(const Params& P, LAS unsigned char* lds, int b, int g, int i) {
    int tid = threadIdx.x; asm volatile("" : "+v"(tid));
    const int w = __builtin_amdgcn_readfirstlane(tid >> 6), lane = tid & 63, r = lane & 31, h = lane >> 5;
    const int rr = w >> 1, qh = w & 1, head = g * 4 + rr;
    const int ql = 32 * qh + r, tq = 64 * i + ql; const size_t trow = (size_t)b * S_ + tq;
    const float slope = fexp2(-(float)(head + 1));
    unsigned char* ws = P.ws;
    const bf16_t* PJQ = (const bf16_t*)(ws + WS_PJQ); const bf16_t* PJKV = (const bf16_t*)(ws + WS_PJKV); const bf16_t* PJG = (const bf16_t*)(ws + WS_PJG);
    bf16x8 qf[4];
#pragma unroll
    for (int kk = 0; kk < 4; ++kk) qf[kk] = scale_q8(*(const bf16x8*)(PJQ + trow * 512 + head * 64 + 16 * kk + 8 * h));
    const float g0 = sigmoidf_(bf2f(PJG[trow * 256 + head * 3 + 0])), g1 = sigmoidf_(bf2f(PJG[trow * 256 + head * 3 + 1])), g2 = sigmoidf_(bf2f(PJG[trow * 256 + head * 3 + 2]));
    LAS unsigned char* kt = lds;
    f32x16 oa0, oa1;
    const int ncmp = 4 * i + 3, ntc = (ncmp + 63) >> 6;
    const bf16_t* KC = (const bf16_t*)(ws + WS_KC) + (size_t)(b * 2 + g) * 256 * 64;
    const bf16_t* VC = (const bf16_t*)(ws + WS_VC) + (size_t)(b * 2 + g) * 256 * 64;
    AttnState st; attn_init(st);
    const unsigned long long cmask = (1ull << ntc) - 1ull;
    const bool need_imp = i > 15;
    LAS float* imp = (LAS float*)(lds + IMP_OFF) + (rr * 64 + ql) * IMP_QS;
    LAS float* mxt = (LAS float*)(lds + MXT_OFF) + (rr * 64 + ql) * 4;
    LAS float* spl = (LAS float*)(lds + SPL_OFF) + (rr * 64 + ql) * 4;
    run_tiles<1>(kt, KC, VC, 64, 64 * 64, cmask, tid, true, [&](const LAS unsigned char* kb, int t) {
        const int dbase = tq - 31 - 1024 * t;
        attn_tile_dyn(64 * i - 31 - 1024 * t < 1008, kb, qf, st, r, h, 16.0f * slope, slope * (float)(64 * h - dbase), [=](int key) { return dbase - 16 * key >= 0; },
            [&](const f32x16& p0, const f32x16& p1, float mx) {
                if (!need_imp) return;
                float carry = 0.f;
#pragma unroll
                for (int kh = 0; kh < 2; ++kh) {
                    float mainv[4], sp[4], recv[4];
#pragma unroll
                    for (int gq = 0; gq < 4; ++gq) { const float a = kh ? p1[4 * gq] : p0[4 * gq], bq = kh ? p1[4 * gq + 1] : p0[4 * gq + 1], c = kh ? p1[4 * gq + 2] : p0[4 * gq + 2], d = kh ? p1[4 * gq + 3] : p0[4 * gq + 3];
                        mainv[gq] = (a + bq) + (c + 0.5f * d); sp[gq] = 0.5f * d; }
#pragma unroll
                    for (int gq = 0; gq < 4; ++gq) recv[gq] = __shfl_xor(sp[gq], 32, 64);
#pragma unroll
                    for (int gq = 0; gq < 4; ++gq) { const float add = h ? recv[gq] : (gq ? recv[gq > 0 ? gq - 1 : 0] : carry);
                        imp[16 * t + 8 * kh + 2 * gq + h] = mainv[gq] + add; }
                    carry = recv[3];
                }
                if (h == 0) { mxt[t] = mx; if (t < 3) spl[t + 1] = carry; }
            }); });
    const float mc = st.m; float lc = st.l + __shfl_xor(st.l, 32, 64); const float invc = lc > 0.f ? 1.0f / lc : 0.f;
    { const float sgc = g0 * invc;
#pragma unroll
      for (int e = 0; e < 16; ++e) { oa0[e] = st.o0[e] * sgc; oa1[e] = st.o1[e] * sgc; } }
    if (need_imp && h == 0) {
#pragma unroll 1
        for (int t = 0; t < ntc; ++t) mxt[t] = fexp2((mxt[t] - mc) * LOG2E) * invc;
    }
    __syncthreads();
    {
        LAS unsigned long long* selm = (LAS unsigned long long*)(lds + SEL_OFF);
        LAS unsigned long long* uni = (LAS unsigned long long*)(lds + UNI_OFF);
        unsigned long long un = 0ull;
        if (i <= 15) { const unsigned long long m = (2ull << i) - 1ull; if (lane < 8) selm[8 * w + lane] = m; un = m; }
        else {
            const LAS float* impb = (const LAS float*)(lds + IMP_OFF);
            const LAS float* fac = (const LAS float*)(lds + MXT_OFF); const LAS float* spb = (const LAS float*)(lds + SPL_OFF);
            const int tl = lane >> 4; const bool head16 = (lane & 15) == 0 && lane > 0;
            const bool cand = (lane >= 1) && (lane <= i - 1);
#pragma unroll 1
            for (int qq = 0; qq < 8; qq += 2) {
                float v[2];
#pragma unroll
                for (int z = 0; z < 2; ++z) { const int q = 8 * w + qq + z; float acc = 0.f;
#pragma unroll
                    for (int hd = 0; hd < 4; ++hd) { const int fo = (hd * 64 + q) * 4;
                        acc += impb[(hd * 64 + q) * IMP_QS + lane] * fac[fo + tl];
                        if (head16) acc += spb[fo + tl] * fac[fo + tl - 1]; }
                    v[z] = acc; }
                const unsigned kb0 = __float_as_uint(v[0]), kb1 = __float_as_uint(v[1]);
                unsigned T0 = 0u, T1 = 0u;
#pragma unroll 1
                for (int bb = 30; bb >= 0; --bb) { const unsigned Tn0 = T0 | (1u << bb), Tn1 = T1 | (1u << bb);
                    const int c0 = __popcll(__ballot(cand && kb0 >= Tn0)), c1 = __popcll(__ballot(cand && kb1 >= Tn1));
                    if (c0 >= 14) T0 = Tn0; if (c1 >= 14) T1 = Tn1; }
#pragma unroll
                for (int z = 0; z < 2; ++z) { const unsigned kb = z ? kb1 : kb0, T = z ? T1 : T0;
                    const unsigned long long gtm = __ballot(cand && kb > T), eqm = __ballot(cand && kb == T);
                    const int need = 14 - __popcll(gtm);
                    const bool seleq = ((eqm >> lane) & 1ull) && (__popcll(eqm & ((1ull << lane) - 1ull)) < need);
                    const bool sel = (lane == 0) || (lane == i) || (cand && kb > T) || seleq;
                    const unsigned long long m = __ballot(sel);
                    if (lane == 0) selm[8 * w + qq + z] = m;
                    un |= m; } }
        }
        if (lane == 0) uni[w] = un;
    }
    __syncthreads();
    unsigned long long myq, un;
    { const LAS unsigned long long* selm = (const LAS unsigned long long*)(lds + SEL_OFF); const LAS unsigned long long* uni = (const LAS unsigned long long*)(lds + UNI_OFF);
      myq = selm[ql]; un = ((uni[0] | uni[1]) | (uni[2] | uni[3])) | ((uni[4] | uni[5]) | (uni[6] | uni[7])); }
    attn_init(st);
    { const bf16_t* kb0 = PJKV + (size_t)b * S_ * 768 + 2 * 128 + g * 64;
      run_tiles<1>(kt, kb0, kb0 + 128, 768, 64 * 768, un & ((2ull << i) - 1ull), tid, true, [&](const LAS unsigned char* kb, int s) {
        const bool selq = (myq >> s) & 1ull; const int dbase = tq - 64 * s;
        attn_tile_dyn(s == i, kb, qf, st, r, h, slope, selq ? slope * (float)(4 * h - dbase) : -1e30f, [=](int key) { return dbase - key >= 0; }); }); }
    { const float l = st.l + __shfl_xor(st.l, 32, 64); const float sg = l > 0.f ? g1 / l : 0.f;
#pragma unroll
      for (int e = 0; e < 16; ++e) { oa0[e] += st.o0[e] * sg; oa1[e] += st.o1[e] * sg; } }
    attn_init(st);
    { const bf16_t* kb0 = PJKV + (size_t)b * S_ * 768 + 4 * 128 + g * 64; const int s0 = i >= 8 ? i - 8 : 0;
      run_tiles<1>(kt, kb0, kb0 + 128, 768, 64 * 768, ((2ull << i) - 1ull) & ~((1ull << s0) - 1ull), tid, true, [&](const LAS unsigned char* kb, int s) {
        const int dbase = tq - 64 * s;
        attn_tile_dyn(s == i || s + 8 == i, kb, qf, st, r, h, slope, slope * (float)(4 * h - dbase), [=](int key) { const int d = dbase - key; return d >= 0 && d < 512; }); }); }
    { const float l = st.l + __shfl_xor(st.l, 32, 64); const float sg = l > 0.f ? g2 / l : 0.f;
#pragma unroll
      for (int e = 0; e < 16; ++e) { oa0[e] += st.o0[e] * sg; oa1[e] += st.o1[e] * sg; } }
    bf16_t* oab = (bf16_t*)P.out + trow * 768 + head * 64;
#pragma unroll
    for (int gq = 0; gq < 4; ++gq) {
        u32x2 w0; w0.x = pk2(oa0[4 * gq], oa0[4 * gq + 1]); w0.y = pk2(oa0[4 * gq + 2], oa0[4 * gq + 3]); *(u32x2*)(oab + 8 * gq + 4 * h) = w0;
        u32x2 w1; w1.x = pk2(oa1[4 * gq], oa1[4 * gq + 1]); w1.y = pk2(oa1[4 * gq + 2], oa1[4 * gq + 3]); *(u32x2*)(oab + 32 + 8 * gq + 4 * h) = w1;
    }
    __syncthreads();
}

#define XB_TMO      128
#define XB_XCNT(j)  (256  + 64 * (j))
#define XB_XSUB(j)  (1280 + 64 * (j))
#define XB_XGEN(j)  (2304 + 64 * (j))
#define XB_TOP      3328
#define XB_TOPGEN   3392
#define XCD_BAR_WORDS 3456
#define XB_SPIN_CAP (1u << 18)
DI unsigned xb_ld(unsigned* p)              { return __hip_atomic_load(p, __ATOMIC_RELAXED, __HIP_MEMORY_SCOPE_AGENT); }
DI unsigned xb_add(unsigned* p, unsigned v) { return __hip_atomic_fetch_add(p, v, __ATOMIC_RELAXED, __HIP_MEMORY_SCOPE_AGENT); }
DI unsigned xb_xcc_id() { return (unsigned)__builtin_amdgcn_s_getreg((3 << 11) | 20) & 0xFu; }
#define XB_SPIN(cond, bar) do { unsigned _sp = 0; while (cond) { __builtin_amdgcn_s_sleep(1); \
    if ((++_sp & 255u) == 0u) { if (xb_ld(&(bar)[XB_TMO])) break; if (_sp > XB_SPIN_CAP) { atomicAdd(&(bar)[XB_TMO], 1u); break; } } } } while (0)
struct XcdBarrier { unsigned* bar; unsigned x; volatile LAS unsigned* st; };
DI void xcd_barrier_complete(unsigned* bar, unsigned x, unsigned& nloc, unsigned& nx) {
    const unsigned G = gridDim.x * gridDim.y * gridDim.z;
    unsigned sum, cnt, mine, sp = 0u;
    for (;;) {
        sum = 0u; cnt = 0u; mine = 0u;
#pragma unroll
        for (unsigned j = 0; j < 16; ++j) { const unsigned c = xb_ld(&bar[XB_XCNT(j)]); sum += c; cnt += (c > 0u) ? 1u : 0u; mine = (j == x) ? c : mine; }
        if (sum == G) break;
        __builtin_amdgcn_s_sleep(1);
        if ((++sp & 255u) == 0u) { if (xb_ld(&bar[XB_TMO])) break; if (sp > XB_SPIN_CAP) { atomicAdd(&bar[XB_TMO], 1u); break; } }
    }
    nloc = mine > 0u ? mine : 1u; nx = cnt > 0u ? cnt : 1u;
}
__device__ __attribute__((noinline)) void xcd_barrier(unsigned* bar, volatile LAS unsigned* st) {
    asm volatile("s_waitcnt vmcnt(0)" ::: "memory");
    __syncthreads();
    if (threadIdx.x == 0) {
        const unsigned x = xb_xcc_id();
        __builtin_amdgcn_s_waitcnt(0);
        unsigned nloc = st[0], nx = st[1];
        if (nloc == 0u) { xcd_barrier_complete(bar, x, nloc, nx); st[0] = nloc; st[1] = nx; }
        const unsigned old = xb_add(&bar[XB_XSUB(x)], 1u);
        const unsigned gen = old / nloc;
        if (old + 1u == (gen + 1u) * nloc) {
            __builtin_amdgcn_fence(__ATOMIC_RELEASE, "agent");
            asm volatile("s_waitcnt vmcnt(0)" ::: "memory");
            const unsigned og = xb_add(&bar[XB_TOP], 1u);
            const unsigned tg = og / nx;
            if (og + 1u == (tg + 1u) * nx) xb_add(&bar[XB_TOPGEN], 1u);
            else XB_SPIN(xb_ld(&bar[XB_TOPGEN]) == tg, bar);
            __builtin_amdgcn_fence(__ATOMIC_ACQUIRE, "agent");
            xb_add(&bar[XB_XGEN(x)], 1u);
            asm volatile("s_waitcnt vmcnt(0)" ::: "memory");
        } else {
            XB_SPIN(xb_ld(&bar[XB_XGEN(x)]) == gen, bar);
            __builtin_amdgcn_fence(__ATOMIC_ACQUIRE, "agent");
            asm volatile("s_waitcnt vmcnt(0)" ::: "memory");
        }
    }
    __syncthreads();
}

DI void ph1(const Params& P, LAS unsigned char* lds, int G, int bid) {
    unsigned char* ws = P.ws;
    pg8::Gemm g{(const bf16_t*)(ws + WS_H1), (const bf16_t*)(ws + WS_WIN), T_, NIN, 1024, 1024, 128}; pg8::StaticOrder S; S.init(T_, NIN, G, bid);
    pg8::EpiProj E{ws}; pg8::gemm_phase(lds, g, S, E);
}
DI void ph2(const Params& P, LAS unsigned char* lds, int G, int bid) {
    if (G == 256) {
        const int x = bid & 7, k = bid >> 3;
        if (k < 16) { cmp_unit(P, lds, bid);
            for (int j = 0; j < 2; ++j) { const int v = (8 + (x >> 1)) * 64 + (x & 1) * 32 + k * 2 + j; dil_unit(P, lds, v / 192, (v / 64) % 3, v % 64); } }
        else for (int j = 0; j < 4; ++j) { const int v = x * 64 + (k - 16) * 4 + j; dil_unit(P, lds, v / 192, (v / 64) % 3, v % 64); }
    } else
    for (int u = bid; u < 128 + 768; u += G) {
        if (u < 128) cmp_unit(P, lds, u);
        else { const int v = u - 128; dil_unit(P, lds, v / 192, (v / 64) % 3, v % 64); }
    }
    __syncthreads();
}
DI void ph3(const Params& P, LAS unsigned char* lds, int G, int bid) {
    unsigned char* ws = P.ws; const int tid = threadIdx.x;
    for (int p0 = bid; p0 < 256; p0 += G) { const int p = (G == 256) ? ((p0 & 7) * 32 + (p0 >> 3)) : p0;
        const int b = p >> 6, g = (p >> 5) & 1, ip = p & 31;
        nsa_unit(P, lds, b, g, 63 - ip); nsa_unit(P, lds, b, g, ip);
        if (DUP_PHASE == 33) { nsa_unit(P, lds, b, g, 63 - ip); nsa_unit(P, lds, b, g, ip); } }
    const bf16_t* OD = (const bf16_t*)(ws + WS_OD); const float* LSE = (const float*)(ws + WS_LSE); bf16_t* oab = (bf16_t*)P.out;
    for (int it = bid * 512 + tid; it < T_ * 32; it += G * 512) { const int t = it >> 5, hh = (it >> 3) & 3, dc = it & 7;
        const float l0 = LSE[(size_t)t * 4 + hh], l1 = LSE[((size_t)T_ + t) * 4 + hh], l2 = LSE[((size_t)2 * T_ + t) * 4 + hh];
        const float mx = fmaxf(l0, fmaxf(l1, l2)); const float e0 = __expf(l0 - mx), e1 = __expf(l1 - mx), e2 = __expf(l2 - mx); const float inv = 1.0f / (e0 + e1 + e2);
        f32x4 a0, a1, b0, b1, c0, c1; pg8::load8(OD + (size_t)t * 256 + hh * 64 + dc * 8, a0, a1); pg8::load8(OD + ((size_t)T_ + t) * 256 + hh * 64 + dc * 8, b0, b1);
        pg8::load8(OD + ((size_t)2 * T_ + t) * 256 + hh * 64 + dc * 8, c0, c1);
        const float w0 = e0 * inv, w1 = e1 * inv, w2 = e2 * inv;
        pg8::store8(oab + (size_t)t * 768 + 512 + hh * 64 + dc * 8, a0 * w0 + b0 * w1 + c0 * w2, a1 * w0 + b1 * w1 + c1 * w2); }
}
DI void ph4(const Params& P, LAS unsigned char* lds, int G, int bid) {
    unsigned char* ws = P.ws;
    pg8::Gemm g{(const bf16_t*)P.out, (const bf16_t*)(ws + WS_WPN), T_, 1024, 768, 768, 128}; pg8::StaticOrder S; S.init(T_, 1024, G, bid);
    pg8::EpiMerge E{(const bf16_t*)(ws + WS_PJM), (bf16_t*)(ws + WS_MIX)}; pg8::gemm_phase<pg8::EpiMerge, 6>(lds, g, S, E);
}
DI void ph5(const Params& P, LAS unsigned char* lds, int G, int bid) {
    unsigned char* ws = P.ws;
    pg8::Gemm g{(const bf16_t*)(ws + WS_MIX), (const bf16_t*)(ws + WS_WOUT), T_, 1024, 1024, 1024, 128}; pg8::StaticOrder S; S.init(T_, 1024, G, bid);
    pg8::EpiResid<1> E{P.x, P.out, (bf16_t*)(ws + WS_A2), P.g_ffn, (float*)(ws + WS_SSQ2)}; pg8::gemm_phase(lds, g, S, E);
}
DI void ph6(const Params& P, LAS unsigned char* lds, int G, int bid) {
    unsigned char* ws = P.ws;
    pg8::Gemm g{(const bf16_t*)(ws + WS_A2), (const bf16_t*)(ws + WS_WUP), T_, NUP, 1024, 1024, 128}; pg8::StaticOrder S; S.init(T_, NUP, G, bid);
    { LAS float* rsall = (LAS float*)(lds + HIDB_OFF + 8192); const float* ssq = (const float*)(ws + WS_SSQ2); pg8::Unit u;
      for (int i = 0; i < 6 && S.next(i, u); ++i) { const int t = threadIdx.x;
          if (t < 256) { const f32x4* sp = (const f32x4*)(ssq + (size_t)(u.pm * 256 + t) * 16); const f32x4 st = (sp[0] + sp[1]) + (sp[2] + sp[3]);
              rsall[i * 256 + t] = __builtin_amdgcn_rsqf(((st[0] + st[1]) + (st[2] + st[3])) * (1.0f / 1024.0f) + RMS_EPS); } }
      __syncthreads(); }
    pg8::EpiUpConv E{(const float*)(ws + WS_SSQ2), (bf16_t*)(ws + WS_ACT), P.conv_w, P.conv_b, (float*)(ws + WS_ULAST), (float*)(ws + WS_UFIRST), (float*)(ws + WS_GFIRST), lds + HIDB_OFF};
    if (DUP_PHASE == 60) { pg8::EpiNull E0; pg8::gemm_phase(lds, g, S, E0); }
    pg8::gemm_phase(lds, g, S, E);
}
DI void ph8(const Params& P, LAS unsigned char* lds, int G, int bid) {
    unsigned char* ws = P.ws; const int tid = threadIdx.x;
    pg8::StaticOrder S; S.init(T_, 1024, G, bid);
    { const float* ulast = (const float*)(ws + WS_ULAST); const float* ufirst = (const float*)(ws + WS_UFIRST); const float* gfirst = (const float*)(ws + WS_GFIRST); bf16_t* act = (bf16_t*)(ws + WS_ACT);
      pg8::Unit u;
      for (int i = 0; S.next(i, u); ++i) { const int pm = u.pm; const bool first = (pm & 15) == 0;
          for (int c = tid; c < DFF; c += 512) {
              const float ul0 = first ? 0.f : ulast[((size_t)(pm - 1) * 2 + 0) * DFF + c], ul1 = first ? 0.f : ulast[((size_t)(pm - 1) * 2 + 1) * DFF + c];
              const float u0 = ufirst[((size_t)pm * 2 + 0) * DFF + c], u1 = ufirst[((size_t)pm * 2 + 1) * DFF + c];
              const float g0 = gfirst[((size_t)pm * 2 + 0) * DFF + c], g1 = gfirst[((size_t)pm * 2 + 1) * DFF + c];
              const float w0 = P.conv_w[c], w1 = P.conv_w[DFF + c], w2 = P.conv_w[2 * DFF + c], cb = P.conv_b[c];
              const float a0 = gelu_tanh(cb + w0 * ul0 + w1 * ul1 + w2 * u0) * g0, a1 = gelu_tanh(cb + w0 * ul1 + w1 * u0 + w2 * u1) * g1;
              act[(size_t)(pm * 256) * DFF + c] = (bf16_t)(pk2(a0, 0.f) & 0xffffu); act[(size_t)(pm * 256 + 1) * DFF + c] = (bf16_t)(pk2(a1, 0.f) & 0xffffu); } }
      asm volatile("s_waitcnt vmcnt(0)" ::: "memory"); __syncthreads(); }
    pg8::Gemm g{(const bf16_t*)(ws + WS_ACT), (const bf16_t*)(ws + WS_WDN), T_, 1024, DFF, DFF, 128};
    if (DUP_PHASE == 8) { pg8::EpiNull E0; pg8::gemm_phase(lds, g, S, E0); }
    if (G == 256) { pg8::EpiFinal E{P.out, P.out, P.g_final, (float*)(ws + WS_SSQ3), (unsigned*)(ws + WS_CTL) + 3520, lds + HIDB_OFF}; pg8::gemm_phase(lds, g, S, E); }
    else { pg8::EpiResid<0> E{P.out, P.out, nullptr, nullptr, (float*)(ws + WS_SSQ3)}; pg8::gemm_phase(lds, g, S, E); }
}
DI void ph9(const Params& P, LAS unsigned char* lds, int G, int bid) {
    unsigned char* ws = P.ws; const int tid = threadIdx.x;
    const int lane = tid & 63, gw = bid * 8 + (tid >> 6), NGW = G * 8; const float* ssq = (const float*)(ws + WS_SSQ3);
    f32x4 gv[4];
#pragma unroll
    for (int j = 0; j < 4; ++j) gv[j] = ((const f32x4*)P.g_final)[lane + 64 * j];
    for (int m = gw; m < T_; m += NGW) {
        const f32x4* sp = (const f32x4*)(ssq + (size_t)m * 16); const f32x4 st = (sp[0] + sp[1]) + (sp[2] + sp[3]);
        const float rstd = 1.0f / sqrtf(((st[0] + st[1]) + (st[2] + st[3])) * (1.0f / 1024.0f) + RMS_EPS);
        f32x4* xr = (f32x4*)(P.out + (size_t)m * D_) + lane;
#pragma unroll
        for (int j = 0; j < 4; ++j) xr[64 * j] = xr[64 * j] * rstd * gv[j];
    }
}

__device__ __attribute__((noinline)) void grid_sync_call() { cg::this_grid().sync(); }
__global__ void __launch_bounds__(512, 2) fwd_megakernel(Params P) {
    extern __shared__ __attribute__((aligned(16))) unsigned char lds_raw[];
    LAS unsigned char* lds = (LAS unsigned char*)lds_raw;
    const int G = gridDim.x, bid = blockIdx.x;
    const int lo = P.ph_lo, hi = P.ph_hi;
    unsigned* barw = (unsigned*)(P.ws + WS_CTL); volatile LAS unsigned* stw = (volatile LAS unsigned*)(lds + ST_OFF);
    if (threadIdx.x < 4) stw[threadIdx.x] = 0u;
    if (threadIdx.x == 0) (void)xb_add(&barw[XB_XCNT(xb_xcc_id())], 1u);
    if (lo < 0) grid_sync_call();
    __syncthreads();
#define IN(k) (lo <= (k) && (k) < hi)
#define SEAM(k) do { if (IN(k) && hi > (k) + 1) xcd_barrier(barw, stw); } while (0)
#ifndef PROBE_SPAN
#define PROBE_SPAN -1
#endif
#define TS0(k) do { if (PROBE_SPAN == (k) && bid == 0 && threadIdx.x == 0) stw[2] = (unsigned)__builtin_amdgcn_s_memrealtime(); } while (0)
#define TS1(k) do { if (PROBE_SPAN == (k) && bid == 0 && threadIdx.x == 0) stw[3] = (unsigned)__builtin_amdgcn_s_memrealtime(); } while (0)
#define PHASE(k, fn) do { TS0(k); if (IN(k)) { fn(P, lds, G, bid); if (DUP_PHASE == (k)) fn(P, lds, G, bid); } SEAM(k); TS1(k); } while (0)
    TS0(0);
    if (IN(0)) { p0_prologue(P, lds); __syncthreads(); if (DUP_PHASE == 0) { p0_prologue(P, lds); __syncthreads(); } }
    SEAM(0); TS1(0);
    PHASE(1, ph1); PHASE(2, ph2); PHASE(3, ph3); PHASE(4, ph4); PHASE(5, ph5); PHASE(6, ph6);
    TS0(8);
    if (IN(8)) ph8(P, lds, G, bid);
    if (G != 256) { SEAM(8); } TS1(8);
    TS0(9);
    if (IN(9) && G != 256) ph9(P, lds, G, bid);
    TS1(9);
    if (PROBE_SPAN >= 0 && bid == 0 && threadIdx.x == 0) { const unsigned t = (unsigned)__builtin_amdgcn_s_memrealtime(), d = stw[3] - stw[2]; while ((unsigned)__builtin_amdgcn_s_memrealtime() - t < d) __builtin_amdgcn_s_sleep(8); }
#undef TS0
#undef TS1
#undef IN
#undef SEAM
#undef PHASE
}

extern "C" void kernel_launch(void* const* d_in, const int* in_sizes, int n_in, void* d_out, int out_size, void* d_ws, size_t ws_size, hipStream_t stream) {
    static int grid = 0;
    if (grid == 0) {
        if (n_in != 18 || ws_size < WS_END) { fprintf(stderr, "kernel_launch: unexpected inputs (n_in %d, ws %zu)\n", n_in, ws_size); grid = -1; return; }
        int dev = 0, cus = 0, per_cu = 0;
        (void)hipGetDevice(&dev); (void)hipDeviceGetAttribute(&cus, hipDeviceAttributeMultiprocessorCount, dev);
        if (hipFuncSetAttribute((const void*)fwd_megakernel, hipFuncAttributeMaxDynamicSharedMemorySize, LDS_BYTES) != hipSuccess) { fprintf(stderr, "hipFuncSetAttribute failed\n"); grid = -1; return; }
        if (hipOccupancyMaxActiveBlocksPerMultiprocessor(&per_cu, (const void*)fwd_megakernel, 512, LDS_BYTES) != hipSuccess || per_cu < 1) per_cu = 1;
        (void)hipGetLastError();
        grid = cus * per_cu;
    }
    if (grid < 0) return;
    if (hipMemsetAsync((char*)d_ws + WS_CTL, 0, CTL_BYTES, stream) != hipSuccess) { fprintf(stderr, "memset failed\n"); return; }
    Params p{};
    const float** f = (const float**)&p;
    for (int i = 0; i < 18; ++i) f[i] = (const float*)d_in[i];
    p.out = (float*)d_out; p.ws = (unsigned char*)d_ws; p.ph_lo = 0; p.ph_hi = 10;
    void* args[] = {&p};
    hipError_t e = hipLaunchCooperativeKernel((const void*)fwd_megakernel, dim3(grid), dim3(512), args, LDS_BYTES, stream);
    if (e != hipSuccess) fprintf(stderr, "cooperative launch failed: %s (grid %d)\n", hipGetErrorString(e), grid);
}
```

```cpp
#include <hip/hip_runtime.h>
#include <hip/hip_cooperative_groups.h>
#include <cstdio>
#include <cstdint>
namespace cg = cooperative_groups;

#define LAS __attribute__((address_space(3)))
#define DI __device__ __forceinline__
typedef unsigned short bf16_t;
typedef short bf16x8 __attribute__((ext_vector_type(8)));
typedef short s16x4 __attribute__((ext_vector_type(4)));
typedef float f32x4 __attribute__((ext_vector_type(4)));
typedef float f32x2 __attribute__((ext_vector_type(2)));
typedef float f32x16 __attribute__((ext_vector_type(16)));
typedef unsigned u32x4 __attribute__((ext_vector_type(4)));
typedef unsigned u32x2 __attribute__((ext_vector_type(2)));
typedef __bf16 bf16x2v __attribute__((ext_vector_type(2)));

constexpr int B_ = 4, S_ = 4096, D_ = 1024, T_ = B_ * S_;
constexpr int NIN = 5888;
constexpr int NINSRC = 5656;
constexpr int DFF = 2816, NUP = 5632;
constexpr float RMS_EPS = 1e-6f;
constexpr float LOG2E = 1.4426950408889634f, LN2 = 0.6931471805599453f;

constexpr size_t MiB = 1u << 20;
constexpr size_t WS_WIN = 0;
constexpr size_t WS_WUP = WS_WIN + (size_t)NIN * 1024 * 2;
constexpr size_t WS_WDN = WS_WUP + (size_t)NUP * 1024 * 2;
constexpr size_t WS_WOUT = WS_WDN + (size_t)1024 * DFF * 2;
constexpr size_t WS_WPN = WS_WOUT + (size_t)1024 * 1024 * 2;
constexpr size_t WS_WPD = WS_WPN + (size_t)1024 * 512 * 2;
constexpr size_t WS_W1K = WS_WPD + (size_t)1024 * 256 * 2;
constexpr size_t WS_W1V = WS_W1K + (size_t)128 * 2048 * 2;
constexpr size_t WS_W2K = WS_W1V + (size_t)128 * 2048 * 2;
constexpr size_t WS_W2V = WS_W2K + (size_t)64 * 128 * 2;
constexpr size_t WS_WEND = WS_W2V + (size_t)64 * 128 * 2;
constexpr size_t WS_R1 = 33 * MiB;
constexpr size_t WS_PJQ = WS_R1, WS_PJKV = WS_R1 + 16 * MiB, WS_PJB = WS_R1 + 40 * MiB, WS_PJM = WS_R1 + 112 * MiB, WS_PJG = WS_R1 + 176 * MiB;
constexpr size_t WS_MIX = WS_R1;
constexpr size_t WS_UG = WS_R1;
constexpr size_t WS_R2 = 217 * MiB;
constexpr size_t WS_H1 = WS_R2, WS_OD = WS_R2, WS_LSE = WS_R2 + 24 * MiB, WS_A2 = WS_R2;
constexpr size_t WS_KC = 249 * MiB, WS_VC = WS_KC + 262144, WS_CTL = WS_KC + 524288, CTL_BYTES = 16384, WS_SSQ2 = 250 * MiB, WS_SSQ3 = 250 * MiB;
constexpr size_t SIDE_BYTES = (size_t)64 * 2 * DFF * 4, WS_ULAST = 251 * MiB, WS_UFIRST = WS_ULAST + SIDE_BYTES, WS_GFIRST = WS_UFIRST + SIDE_BYTES, WS_END = WS_GFIRST + SIDE_BYTES;
constexpr size_t WS_ACT = WS_R1;
static_assert(WS_END <= 256 * MiB, "ws");
static_assert(WS_WEND <= WS_R1, "weights");

constexpr int LDS_BYTES = 147456;
constexpr int KT_STRIDE = 144, VT_STRIDE = 136, VT_OFF = 64 * KT_STRIDE, KV_REGION = VT_OFF + 64 * VT_STRIDE;
constexpr int IMP_OFF = 73728, IMP_QS = 65, IMP_BYTES = 4 * 64 * IMP_QS * 4;
constexpr int SEL_OFF = IMP_OFF + IMP_BYTES, UNI_OFF = SEL_OFF + 512;
static_assert(UNI_OFF + 64 <= LDS_BYTES, "lds");
constexpr int HIDB_OFF = 131072, HIDB_STRIDE = 272;
constexpr int MXT_OFF = 36864, SPL_OFF = 40960;
static_assert(2 * KV_REGION <= MXT_OFF && SPL_OFF + 4096 <= IMP_OFF, "lds nsa");
constexpr int ST_OFF = LDS_BYTES - 16;

struct Params {
    const float *x, *g_mix, *w_in, *pe_k, *w_k1, *w_k2, *pe_v, *w_v1, *w_v2, *w_pn, *w_pd, *w_out, *g_ffn, *w_up, *conv_w, *conv_b, *w_down, *g_final;
    float* out; unsigned char* ws; int ph_lo, ph_hi;
};

DI float bf2f(unsigned v) { return __builtin_bit_cast(float, v << 16); }
DI unsigned pk2(float a, float b) { f32x2 v = {a, b}; return __builtin_bit_cast(unsigned, __builtin_convertvector(v, bf16x2v)); }
DI float wave_sum(float v) {
#pragma unroll
    for (int o = 1; o < 64; o <<= 1) v += __shfl_xor(v, o, 64);
    return v;
}
DI float fexp2(float x) { return __builtin_amdgcn_exp2f(x); }
DI float sigmoidf_(float x) { return __builtin_amdgcn_rcpf(1.0f + fexp2(-LOG2E * x)); }
DI float gelu_tanh(float x) {
    const float t = x * x;
    const float u = __builtin_fmaf(t, -2.0f * LOG2E * 0.7978845608028654f * 0.044715f, -2.0f * LOG2E * 0.7978845608028654f);
    const float e = fexp2(x * u);
    return x * __builtin_amdgcn_rcpf(1.0f + e);
}
DI int crow(int i, int h) { return (i & 3) + 8 * (i >> 2) + 4 * h; }
#define MFMA32(a, b, c) __builtin_amdgcn_mfma_f32_32x32x16_bf16((a), (b), (c), 0, 0, 0)

namespace pg8 {
constexpr int BM = 256, BK = 64, HALF = 128, HTB = HALF * BK * 2, NXCD = 8, WGM = 4;
DI int lds_byte(int r, int c) { const int st = (r >> 4) * 2 + (c >> 5), rr = r & 15, cc = c & 31, ob = rr * 64 + cc * 2; return st * 1024 + (ob ^ (((ob >> 9) & 1) << 5)); }
DI void stage_rc(int b, int& R, int& C) { const int st = b / 1024, sb = b % 1024, swz = sb ^ (((sb >> 9) & 1) << 5); R = (st >> 1) * 16 + swz / 64; C = (st & 1) * 32 + (swz % 64) / 2; }
DI int perm32(int rho) { const int n = rho >> 4, i = rho & 15; return 8 * (i >> 2) + 4 * n + (i & 3); }
struct Unit { int pm, pn, idx; };
struct Gemm { const bf16_t* A; const bf16_t* Bt; int M, N, K, lda, apair; };
struct StaticOrder {
    int nM, nN, nwg, G, c;
    DI void init(int M, int N, int G_, int c_) { nM = M / BM; nN = N / BM; nwg = nM * nN; G = G_; c = c_; }
    DI bool next(int i, Unit& u) const {
        const long L = (long)i * G + c; if (L >= nwg) return false;
        int wgid = (int)L; { const int q = nwg / NXCD, r = nwg % NXCD, xcd = wgid % NXCD, off = wgid / NXCD; wgid = (xcd < r ? xcd * (q + 1) : r * (q + 1) + (xcd - r) * q) + off; }
        const int nig = WGM * nN, gid = wgid / nig, fm = gid * WGM, gsz = (nM - fm) < WGM ? (nM - fm) : WGM;
        u.pm = fm + ((wgid % nig) % gsz); u.pn = (wgid % nig) / gsz; u.idx = i; return true;
    }
};
template <class Epi, int HOOK_T = -1>
DI void gemm_phase(LAS unsigned char* lds, const Gemm g, const StaticOrder& S, const Epi& E) {
    const int tid = threadIdx.x, wid = __builtin_amdgcn_readfirstlane(tid >> 6), lane = tid & 63, wr = wid >> 2, wc = wid & 3, fr = lane & 15, fq = lane >> 4;
    const int K = g.K, nt = K / BK, lda = g.lda;
    unsigned voffA[2], voffB[2];
#pragma unroll
    for (int i = 0; i < 2; ++i) { int R, C; stage_rc(tid * 16 + i * 8192, R, C); const int Rb = (R & ~31) + perm32(R & 31);
        voffA[i] = (unsigned)(R * lda + C) * 2u; voffB[i] = (unsigned)(Rb * K + C) * 2u; }
    const size_t kstep = (size_t)(BK * 2);
    const size_t apairB = (size_t)g.apair * 2;
    const size_t hstepA = (size_t)HALF * lda * 2, tstepA = 2 * hstepA;
    const size_t hstepB = (size_t)HALF * K * 2, tstepB = 2 * hstepB;
    const unsigned ldsw = (unsigned)wid * 1024u;
    const int aoff = lds_byte(wr * 64 + fr, fq * 8), boff = lds_byte(wc * 32 + fr, fq * 8);
#define PG8_SA(b, h) (((b) * 2 + (h)) * HTB)
#define PG8_SB(b, h) ((4 + (b) * 2 + (h)) * HTB)
#define PG8_STAGE(bufoff, gbase, voff) do { _Pragma("unroll") for (int _i = 0; _i < 2; ++_i) \
        __builtin_amdgcn_global_load_lds((const unsigned*)((const char*)(gbase) + (voff)[_i]), (LAS unsigned*)(lds + (bufoff) + ldsw + _i * 8192), 16, 0, 0); } while (0)
#define PG8_LDA(dst, b, h) do { _Pragma("unroll") for (int m = 0; m < 4; ++m) _Pragma("unroll") for (int k = 0; k < 2; ++k) dst[m][k] = *(const LAS bf16x8*)(lds + PG8_SA(b, h) + aoff + m * 2048 + k * 1024); } while (0)
#define PG8_LDB(dst, b, h) do { _Pragma("unroll") for (int n = 0; n < 2; ++n) _Pragma("unroll") for (int k = 0; k < 2; ++k) dst[n][k] = *(const LAS bf16x8*)(lds + PG8_SB(b, h) + boff + n * 2048 + k * 1024); } while (0)
#define PG8_MMA(ai, bj, At, Bt) do { __builtin_amdgcn_s_setprio(1); _Pragma("unroll") for (int m = 0; m < 4; ++m) _Pragma("unroll") for (int n = 0; n < 2; ++n) _Pragma("unroll") for (int k = 0; k < 2; ++k) \
        acc[ai][bj][m][n] = __builtin_amdgcn_mfma_f32_16x16x32_bf16(Bt[n][k], At[m][k], acc[ai][bj][m][n], 0, 0, 0); __builtin_amdgcn_s_setprio(0); } while (0)
#define PG8_WAIT_V(n) asm volatile("s_waitcnt vmcnt(" #n ")" ::: "memory")
#define PG8_WAIT_L(n) asm volatile("s_waitcnt lgkmcnt(" #n ")" ::: "memory")
#define PG8_BAR __builtin_amdgcn_s_barrier()
#define PG8_SCHED __builtin_amdgcn_sched_barrier(0)
    Unit cur, nxt; int ui = 0;
    if (!S.next(0, cur)) return;
    f32x4 acc[2][2][4][2];
#pragma unroll
    for (int a = 0; a < 2; ++a)
#pragma unroll
        for (int b = 0; b < 2; ++b)
#pragma unroll
            for (int m = 0; m < 4; ++m)
#pragma unroll
                for (int n = 0; n < 2; ++n) acc[a][b][m][n] = (f32x4){0.f, 0.f, 0.f, 0.f};
    bf16x8 At[4][2], B0[2][2], B1[2][2];
    const char* cA = (const char*)g.A + (size_t)cur.pm * tstepA; const char* cB = (const char*)g.Bt + (size_t)cur.pn * tstepB;
    PG8_STAGE(PG8_SB(0, 0), cB, voffB); PG8_STAGE(PG8_SB(0, 1), cB + hstepB, voffB); PG8_STAGE(PG8_SA(0, 0), cA, voffA); PG8_STAGE(PG8_SA(0, 1), cA + hstepA, voffA);
    if (wr == 1) PG8_BAR;
    PG8_WAIT_V(2); PG8_BAR;
    PG8_STAGE(PG8_SB(1, 0), cB + kstep, voffB); PG8_STAGE(PG8_SA(1, 0), cA + kstep, voffA); PG8_STAGE(PG8_SB(1, 1), cB + hstepB + kstep, voffB);
    PG8_WAIT_V(6); PG8_BAR;
    for (;;) {
        const bool has_next = S.next(ui + 1, nxt);
        const char* nA = has_next ? (const char*)g.A + (size_t)nxt.pm * tstepA : cA; const char* nB = has_next ? (const char*)g.Bt + (size_t)nxt.pn * tstepB : cB;
        for (int t = 0; t < nt; t += 2) {
            const bool last = (t == nt - 2);
            const char* a1 = cA + (size_t)(t >> 1) * apairB + kstep;
            const char* a2 = last ? nA : cA + (size_t)((t >> 1) + 1) * apairB; const char* b2 = last ? nB : cB + (size_t)(t + 2) * kstep;
            const char* a3 = a2 + kstep; const char* b3 = b2 + kstep;
            PG8_LDB(B0, 0, 0); PG8_LDB(B1, 0, 1); PG8_SCHED; PG8_LDA(At, 0, 0); PG8_STAGE(PG8_SA(1, 1), a1 + hstepA, voffA);
            PG8_WAIT_V(8); PG8_WAIT_L(0); PG8_BAR; PG8_MMA(0, 0, At, B0); PG8_MMA(0, 1, At, B1); PG8_BAR; PG8_SCHED;
            PG8_LDA(At, 0, 1); PG8_STAGE(PG8_SB(0, 0), b2, voffB); PG8_STAGE(PG8_SB(0, 1), b2 + hstepB, voffB); PG8_STAGE(PG8_SA(0, 0), a2, voffA);
            PG8_WAIT_V(8); PG8_WAIT_L(0); PG8_BAR; PG8_MMA(1, 0, At, B0); PG8_MMA(1, 1, At, B1); PG8_BAR; PG8_SCHED;
            PG8_LDB(B0, 1, 0); PG8_LDB(B1, 1, 1); PG8_SCHED; PG8_LDA(At, 1, 0); PG8_STAGE(PG8_SA(0, 1), a2 + hstepA, voffA);
            PG8_WAIT_V(8); PG8_WAIT_L(0); PG8_BAR; PG8_MMA(0, 0, At, B0); PG8_MMA(0, 1, At, B1); PG8_BAR; PG8_SCHED;
            PG8_LDA(At, 1, 1); PG8_STAGE(PG8_SB(1, 0), b3, voffB); PG8_STAGE(PG8_SB(1, 1), b3 + hstepB, voffB); PG8_STAGE(PG8_SA(1, 0), a3, voffA);
            PG8_WAIT_V(8); PG8_WAIT_L(0); PG8_BAR; PG8_MMA(1, 0, At, B0); PG8_MMA(1, 1, At, B1); PG8_BAR; PG8_SCHED;
            if constexpr (HOOK_T >= 0) { if (t == HOOK_T) { E.hook(acc, cur, wr, wc, fr, fq); PG8_SCHED; } }
        }
        if (wr == 0) PG8_BAR;
        E(acc, cur, wr, wc, fr, fq);
        if (!has_next) break;
#pragma unroll
        for (int a = 0; a < 2; ++a)
#pragma unroll
            for (int b = 0; b < 2; ++b)
#pragma unroll
                for (int m = 0; m < 4; ++m)
#pragma unroll
                    for (int n = 0; n < 2; ++n) acc[a][b][m][n] = (f32x4){0.f, 0.f, 0.f, 0.f};
        cur = nxt; cA = nA; cB = nB; ++ui;
        if (wr == 1) PG8_BAR;
    }
    PG8_WAIT_V(0);
    PG8_BAR;
#undef PG8_SA
#undef PG8_SB
#undef PG8_STAGE
#undef PG8_LDA
#undef PG8_LDB
#undef PG8_MMA
#undef PG8_WAIT_V
#undef PG8_WAIT_L
#undef PG8_BAR
#undef PG8_SCHED
}
typedef f32x4 Acc[2][2][4][2];
DI void store8(bf16_t* p, f32x4 v0, f32x4 v1) { u32x4 w; w.x = pk2(v0[0], v0[1]); w.y = pk2(v0[2], v0[3]); w.z = pk2(v1[0], v1[1]); w.w = pk2(v1[2], v1[3]); *(u32x4*)p = w; }
DI void load8(const bf16_t* p, f32x4& v0, f32x4& v1) { const u32x4 w = *(const u32x4*)p;
    v0 = (f32x4){bf2f(w.x & 0xffffu), bf2f(w.x >> 16), bf2f(w.y & 0xffffu), bf2f(w.y >> 16)}; v1 = (f32x4){bf2f(w.z & 0xffffu), bf2f(w.z >> 16), bf2f(w.w & 0xffffu), bf2f(w.w >> 16)}; }

struct EpiProj {
    unsigned char* ws;
    DI void operator()(Acc& acc, const Unit& u, int wr, int wc, int fr, int fq) const {
        const int pn = u.pn; bf16_t* base; int ld, ct;
        if (pn < 2) { base = (bf16_t*)(ws + WS_PJQ); ld = 512; ct = pn; }
        else if (pn < 5) { base = (bf16_t*)(ws + WS_PJKV); ld = 768; ct = pn - 2; }
        else if (pn < 14) { base = (bf16_t*)(ws + WS_PJB); ld = 2304; ct = pn - 5; }
        else if (pn < 22) { base = (bf16_t*)(ws + WS_PJM); ld = 2048; ct = pn - 14; }
        else { base = (bf16_t*)(ws + WS_PJG); ld = 256; ct = 0; }
        const int row0 = u.pm * BM + wr * 64 + fr, col0 = ct * 256 + wc * 32 + 8 * fq;
#pragma unroll
        for (int ai = 0; ai < 2; ++ai)
#pragma unroll
            for (int m = 0; m < 4; ++m) { bf16_t* rowp = base + (size_t)(row0 + ai * HALF + m * 16) * ld + col0;
#pragma unroll
                for (int bj = 0; bj < 2; ++bj) { f32x4 v0 = acc[ai][bj][m][0], v1 = acc[ai][bj][m][1];
                    if (pn >= 14 && pn < 22) {
#pragma unroll
                        for (int e = 0; e < 4; ++e) { v0[e] = sigmoidf_(v0[e]); v1[e] = sigmoidf_(v1[e]); } }
                    store8(rowp + bj * HALF, v0, v1); } }
    }
};
struct EpiMerge {
    const bf16_t* gate; bf16_t* mix;
    DI void hook(Acc& acc, const Unit& u, int wr, int wc, int fr, int fq) const {
        asm volatile("" : "+v"(fr), "+v"(fq));
        const int row0 = u.pm * BM + wr * 64 + fr, col0 = u.pn * BM + wc * 32 + 8 * fq;
#pragma unroll
        for (int ai = 0; ai < 2; ++ai)
#pragma unroll
            for (int m = 0; m < 4; ++m) { const size_t row = (size_t)(row0 + ai * HALF + m * 16);
#pragma unroll
                for (int bj = 0; bj < 2; ++bj) { const int col = col0 + bj * HALF;
                    f32x4 a0, a1, b0, b1; load8(gate + row * 2048 + col, a0, a1); load8(gate + row * 2048 + 1024 + col, b0, b1);
#pragma unroll
                    for (int e = 0; e < 4; ++e) { acc[ai][bj][m][0][e] *= a0[e] * __builtin_amdgcn_rcpf(b0[e]); acc[ai][bj][m][1][e] *= a1[e] * __builtin_amdgcn_rcpf(b1[e]); } }
                asm volatile("" ::: "memory"); }
    }
    DI void operator()(Acc& acc, const Unit& u, int wr, int wc, int fr, int fq) const {
        const int row0 = u.pm * BM + wr * 64 + fr, col0 = u.pn * BM + wc * 32 + 8 * fq;
        u32x4 cg[2], ng[2];
#pragma unroll
        for (int bj = 0; bj < 2; ++bj) cg[bj] = *(const u32x4*)(gate + (size_t)row0 * 2048 + 1024 + col0 + bj * HALF);
#pragma unroll
        for (int g = 0; g < 8; ++g) { const int ai = g >> 2, m = g & 3; const size_t row = (size_t)(row0 + ai * HALF + m * 16);
            if (g < 7) { const size_t row2 = (size_t)(row0 + ((g + 1) >> 2) * HALF + ((g + 1) & 3) * 16);
#pragma unroll
                for (int bj = 0; bj < 2; ++bj) ng[bj] = *(const u32x4*)(gate + row2 * 2048 + 1024 + col0 + bj * HALF); }
#pragma unroll
            for (int bj = 0; bj < 2; ++bj) { const u32x4 w = cg[bj];
                const f32x4 b0 = {bf2f(w.x & 0xffffu), bf2f(w.x >> 16), bf2f(w.y & 0xffffu), bf2f(w.y >> 16)}, b1 = {bf2f(w.z & 0xffffu), bf2f(w.z >> 16), bf2f(w.w & 0xffffu), bf2f(w.w >> 16)};
                store8(mix + row * 1024 + col0 + bj * HALF, acc[ai][bj][m][0] * b0, acc[ai][bj][m][1] * b1); }
            cg[0] = ng[0]; cg[1] = ng[1]; }
    }
};
template <int WRITE_A2> struct EpiResid {
    const float* xi; float* xo; bf16_t* a2; const float* gw; float* ssq;
    DI void operator()(Acc& acc, const Unit& u, int wr, int wc, int fr, int fq) const {
        const int row0 = u.pm * BM + wr * 64 + fr, col0 = u.pn * BM + wc * 32 + 8 * fq;
        f32x4 cx[4], nx[4], wg[4];
#pragma unroll
        for (int bj = 0; bj < 2; ++bj) { const float* p = xi + (size_t)row0 * 1024 + col0 + bj * HALF; cx[2 * bj] = *(const f32x4*)p; cx[2 * bj + 1] = *(const f32x4*)(p + 4);
            if (WRITE_A2) { wg[2 * bj] = *(const f32x4*)(gw + col0 + bj * HALF); wg[2 * bj + 1] = *(const f32x4*)(gw + col0 + bj * HALF + 4); } }
#pragma unroll
        for (int g = 0; g < 8; ++g) { const int ai = g >> 2, m = g & 3; const size_t row = (size_t)(row0 + ai * HALF + m * 16); float ss = 0.f;
            if (g < 7) { const int ai2 = (g + 1) >> 2, m2 = (g + 1) & 3; const size_t row2 = (size_t)(row0 + ai2 * HALF + m2 * 16);
#pragma unroll
                for (int bj = 0; bj < 2; ++bj) { const float* p = xi + row2 * 1024 + col0 + bj * HALF; nx[2 * bj] = *(const f32x4*)p; nx[2 * bj + 1] = *(const f32x4*)(p + 4); } }
#pragma unroll
            for (int bj = 0; bj < 2; ++bj) { const int col = col0 + bj * HALF;
                const f32x4 v0 = acc[ai][bj][m][0] + cx[2 * bj], v1 = acc[ai][bj][m][1] + cx[2 * bj + 1];
                *(f32x4*)(xo + row * 1024 + col) = v0; *(f32x4*)(xo + row * 1024 + col + 4) = v1;
                ss += (v0[0] * v0[0] + v0[1] * v0[1]) + (v0[2] * v0[2] + v0[3] * v0[3]) + (v1[0] * v1[0] + v1[1] * v1[1]) + (v1[2] * v1[2] + v1[3] * v1[3]);
                if (WRITE_A2) store8(a2 + row * 1024 + col, v0 * wg[2 * bj], v1 * wg[2 * bj + 1]); }
            ss += __shfl_xor(ss, 16, 64); ss += __shfl_xor(ss, 32, 64);
            if (fq == 0) ssq[row * 16 + u.pn * 4 + wc] = ss;
#pragma unroll
            for (int q = 0; q < 4; ++q) cx[q] = nx[q]; }
    }
};
struct EpiFinal {
    const float* xi; float* xo; const float* gw; float* ssq; unsigned* cnt; LAS unsigned char* xlds;
    DI void operator()(Acc& acc, const Unit& u, int wr, int wc, int fr, int fq) const {
        asm volatile("" : "+v"(fr), "+v"(fq));
        const int lane = fr + 16 * fq, t = (wr * 4 + wc) * 64 + lane;
        const int row0 = u.pm * BM + wr * 64 + fr, col0 = u.pn * BM + wc * 32 + 8 * fq;
        f32x4 cx[4], nx[4];
#pragma unroll
        for (int bj = 0; bj < 2; ++bj) { const float* p = xi + (size_t)row0 * 1024 + col0 + bj * HALF; cx[2 * bj] = *(const f32x4*)p; cx[2 * bj + 1] = *(const f32x4*)(p + 4); }
#pragma unroll
        for (int g = 0; g < 8; ++g) { const int ai = g >> 2, m = g & 3; const size_t row = (size_t)(row0 + ai * HALF + m * 16); float ss = 0.f;
            if (g < 7) { const size_t row2 = (size_t)(row0 + ((g + 1) >> 2) * HALF + ((g + 1) & 3) * 16);
#pragma unroll
                for (int bj = 0; bj < 2; ++bj) { const float* p = xi + row2 * 1024 + col0 + bj * HALF; nx[2 * bj] = *(const f32x4*)p; nx[2 * bj + 1] = *(const f32x4*)(p + 4); } }
#pragma unroll
            for (int bj = 0; bj < 2; ++bj) { const f32x4 v0 = acc[ai][bj][m][0] + cx[2 * bj], v1 = acc[ai][bj][m][1] + cx[2 * bj + 1];
                acc[ai][bj][m][0] = v0; acc[ai][bj][m][1] = v1;
                ss += (v0[0] * v0[0] + v0[1] * v0[1]) + (v0[2] * v0[2] + v0[3] * v0[3]) + (v1[0] * v1[0] + v1[1] * v1[1]) + (v1[2] * v1[2] + v1[3] * v1[3]); }
            ss += __shfl_xor(ss, 16, 64); ss += __shfl_xor(ss, 32, 64);
            if (fq == 0) ssq[row * 16 + u.pn * 4 + wc] = ss;
#pragma unroll
            for (int q = 0; q < 4; ++q) cx[q] = nx[q]; }
        f32x4 gwv[4];
#pragma unroll
        for (int bj = 0; bj < 2; ++bj) { gwv[2 * bj] = *(const f32x4*)(gw + col0 + bj * HALF); gwv[2 * bj + 1] = *(const f32x4*)(gw + col0 + bj * HALF + 4); }
        asm volatile("s_waitcnt vmcnt(0)" ::: "memory");
        __syncthreads();
        if (t == 0) {
            __builtin_amdgcn_fence(__ATOMIC_RELEASE, "agent"); asm volatile("s_waitcnt vmcnt(0)" ::: "memory");
            (void)__hip_atomic_fetch_add(cnt + u.pm, 1u, __ATOMIC_RELAXED, __HIP_MEMORY_SCOPE_AGENT);
            unsigned sp = 0;
            while (__hip_atomic_load(cnt + u.pm, __ATOMIC_RELAXED, __HIP_MEMORY_SCOPE_AGENT) < 4u) { __builtin_amdgcn_s_sleep(1); if (++sp > (1u << 22)) break; }
            __builtin_amdgcn_fence(__ATOMIC_ACQUIRE, "agent"); asm volatile("s_waitcnt vmcnt(0)" ::: "memory");
        }
        __syncthreads();
        LAS float* rs = (LAS float*)xlds;
        if (t < 256) { const f32x4* sp = (const f32x4*)(ssq + (size_t)(u.pm * BM + t) * 16); const f32x4 st = (sp[0] + sp[1]) + (sp[2] + sp[3]);
            rs[t] = 1.0f / sqrtf(((st[0] + st[1]) + (st[2] + st[3])) * (1.0f / 1024.0f) + RMS_EPS); }
        __syncthreads();
#pragma unroll
        for (int ai = 0; ai < 2; ++ai)
#pragma unroll
            for (int m = 0; m < 4; ++m) { const int rl = ai * HALF + wr * 64 + m * 16 + fr; const size_t row = (size_t)(u.pm * BM + rl); const float rstd = rs[rl];
#pragma unroll
                for (int bj = 0; bj < 2; ++bj) { const int col = col0 + bj * HALF;
                    *(f32x4*)(xo + row * 1024 + col) = acc[ai][bj][m][0] * rstd * gwv[2 * bj]; *(f32x4*)(xo + row * 1024 + col + 4) = acc[ai][bj][m][1] * rstd * gwv[2 * bj + 1]; } }
    }
};
DI void store4(bf16_t* p, f32x4 v) { u32x2 w; w.x = pk2(v[0], v[1]); w.y = pk2(v[2], v[3]); *(u32x2*)p = w; }
struct EpiUpConv {
    const float* ssq; bf16_t* act; const float* conv_w; const float* conv_b; float* ulast; float* ufirst; float* gfirst; LAS unsigned char* xlds;
    DI void operator()(Acc& acc, const Unit& u, int wr, int wc, int fr, int fq) const {
        asm volatile("" : "+v"(fr), "+v"(fq));
        const int lane = fr + 16 * fq;
        const int colg = u.pn * 128 + wc * 32 + 8 * fq;
        LAS float* xs = (LAS float*)xlds;
        const LAS float* rs = (const LAS float*)(xlds + 8192) + u.idx * 256;
#pragma unroll
        for (int ai = 0; ai < 2; ++ai)
#pragma unroll
            for (int m = 0; m < 4; ++m) { const float rstd = rs[ai * HALF + wr * 64 + m * 16 + fr];
#pragma unroll
                for (int bj = 0; bj < 2; ++bj)
#pragma unroll
                    for (int n = 0; n < 2; ++n) acc[ai][bj][m][n] *= rstd; }
        if (fr >= 14) {
#pragma unroll
            for (int ai = 0; ai < 2; ++ai) { LAS float* slot = xs + ((((ai * 2 + wr) * 4 + wc) * 2 + (fr - 14)) * 4 + fq) * 8;
                *(LAS f32x4*)slot = acc[ai][0][3][0]; *(LAS f32x4*)(slot + 4) = acc[ai][0][3][1]; }
            if (wr == 1) { float* p = ulast + ((size_t)u.pm * 2 + (fr - 14)) * DFF + colg; *(f32x4*)p = acc[1][0][3][0]; *(f32x4*)(p + 4) = acc[1][0][3][1]; }
        }
        if (fr < 2 && wr == 0) { float* p = ufirst + ((size_t)u.pm * 2 + fr) * DFF + colg; *(f32x4*)p = acc[0][0][0][0]; *(f32x4*)(p + 4) = acc[0][0][0][1];
            float* q = gfirst + ((size_t)u.pm * 2 + fr) * DFF + colg; *(f32x4*)q = acc[0][1][0][0]; *(f32x4*)(q + 4) = acc[0][1][0][1]; }
        __syncthreads();
#pragma unroll
        for (int n = 0; n < 2; ++n) {
            const f32x4 w0 = *(const f32x4*)(conv_w + colg + 4 * n), w1 = *(const f32x4*)(conv_w + DFF + colg + 4 * n), w2 = *(const f32x4*)(conv_w + 2 * DFF + colg + 4 * n), cb = *(const f32x4*)(conv_b + colg + 4 * n);
#pragma unroll
            for (int ai = 0; ai < 2; ++ai) {
                f32x4 r1p = {0.f, 0.f, 0.f, 0.f}, r2p = r1p;
                if (ai == 1 || wr == 1) { const int pai = wr ? ai : ai - 1, pwr = wr ? 0 : 1;
                    const f32x4 p1 = *(const LAS f32x4*)(xs + ((((pai * 2 + pwr) * 4 + wc) * 2 + 1) * 4 + fq) * 8 + 4 * n), p2 = *(const LAS f32x4*)(xs + ((((pai * 2 + pwr) * 4 + wc) * 2 + 0) * 4 + fq) * 8 + 4 * n);
                    r1p = p1; r2p = fr == 0 ? p2 : p1; }
#pragma unroll
                for (int m = 0; m < 4; ++m) {
                    const f32x4 ua = acc[ai][0][m][n];
                    f32x4 r1, r2;
#pragma unroll
                    for (int e = 0; e < 4; ++e) { r1[e] = __int_as_float(__builtin_amdgcn_update_dpp(0, __float_as_int(ua[e]), 0x121, 0xf, 0xf, false));
                        r2[e] = __int_as_float(__builtin_amdgcn_update_dpp(0, __float_as_int(ua[e]), 0x122, 0xf, 0xf, false)); }
                    const f32x4 pv1 = fr >= 1 ? r1 : r1p, pv2 = fr >= 2 ? r2 : r2p;
                    f32x4 v = cb + w0 * pv2 + w1 * pv1 + w2 * ua;
                    const f32x4 ga = acc[ai][1][m][n];
#pragma unroll
                    for (int e = 0; e < 4; ++e) v[e] = gelu_tanh(v[e]) * ga[e];
                    const bool skip = (ai == 0 && m == 0 && wr == 0 && fr < 2);
                    if (!skip) store4(act + (size_t)(u.pm * BM + ai * HALF + wr * 64 + m * 16 + fr) * DFF + colg + 4 * n, v);
                    r1p = r1; r2p = r2;
                    asm volatile("" ::: "memory");
                }
            }
        }
    }
};
struct EpiNull { DI void operator()(Acc& acc, const Unit& u, int wr, int wc, int fr, int fq) const { if (acc[0][0][0][0][0] == 1234.5f) *(volatile int*)nullptr = 0; } };
}

#ifndef DUP_PHASE
#define DUP_PHASE -1
#endif
DI int rowmap(int mode, int n) {
    if (mode == 1) { if (n < 1280) return n; if (n < 1304) return 5632 + (n - 1280); return n - 24; }
    if (mode == 2) { if (n < DFF) return (n >> 7) * 256 + (n & 127); const int q = n - DFF; return (q >> 7) * 256 + 128 + (q & 127); }
    return n;
}
DI void transpose_item(const float* W, int K, int N, bf16_t* WT, int ldt, int mode, LAS float* scr, int item, int lane) {
    const int nblk = (N + 31) / 32, kb = item / nblk, nb = item % nblk, k0 = 64 * kb, n0 = 32 * nb;
    const int nl = n0 + (lane & 31);
    float tv[32];
    const float* wp = W + (size_t)(k0 + (lane >> 5)) * N + (nl < N ? nl : 0);
#pragma unroll
    for (int i = 0; i < 32; ++i) tv[i] = wp[(size_t)(2 * i) * N];
#pragma unroll
    for (int i = 0; i < 32; ++i) scr[(2 * i + (lane >> 5)) * 33 + (lane & 31)] = tv[i];
    asm volatile("s_waitcnt lgkmcnt(0)" ::: "memory");
    const int c = lane & 7;
#pragma unroll
    for (int j = 0; j < 4; ++j) { const int n = (lane >> 3) + 8 * j; const LAS float* s = scr + (8 * c) * 33 + n;
        u32x4 o; o.x = pk2(s[0 * 33], s[1 * 33]); o.y = pk2(s[2 * 33], s[3 * 33]); o.z = pk2(s[4 * 33], s[5 * 33]); o.w = pk2(s[6 * 33], s[7 * 33]);
        if (n0 + n < N) *(u32x4*)(WT + (size_t)rowmap(mode, n0 + n) * ldt + k0 + 8 * c) = o; }
    asm volatile("s_waitcnt lgkmcnt(0)" ::: "memory");
}
DI void p0_prologue(const Params& P, LAS unsigned char* lds) {
    const int tid = threadIdx.x, lane = tid & 63, wave = tid >> 6;
    LAS float* scr = (LAS float*)(lds + wave * 16384);
    const int gw = blockIdx.x * 8 + wave, NGW = gridDim.x * 8;
    unsigned char* ws = P.ws;
    int base = 0;
#define DOJOB(W_, K_, N_, OFF_, MODE_, LDT_) do { const int items = ((K_) / 64) * (((N_) + 31) / 32); \
        int first = gw - (base % NGW); if (first < 0) first += NGW; \
        for (int it = first; it < items; it += NGW) transpose_item((W_), (K_), (N_), (bf16_t*)(ws + (OFF_)), (LDT_), (MODE_), scr, it, lane); \
        base += items; } while (0)
    DOJOB(P.w_in, 1024, NINSRC, WS_WIN, 1, 1024); DOJOB(P.w_up, 1024, NUP, WS_WUP, 2, 1024); DOJOB(P.w_down, DFF, 1024, WS_WDN, 0, DFF); DOJOB(P.w_out, 1024, 1024, WS_WOUT, 0, 1024);
    DOJOB(P.w_pn, 512, 1024, WS_WPN, 0, 768); DOJOB(P.w_pd, 256, 1024, WS_WPN + 1024, 0, 768); DOJOB(P.w_k1, 2048, 128, WS_W1K, 0, 2048); DOJOB(P.w_v1, 2048, 128, WS_W1V, 0, 2048);
    DOJOB(P.w_k2, 128, 64, WS_W2K, 0, 128); DOJOB(P.w_v2, 128, 64, WS_W2V, 0, 128);
#undef DOJOB
    { u32x4* z = (u32x4*)(ws + WS_WIN + (size_t)NINSRC * 1024 * 2); const int n16 = (NIN - NINSRC) * 1024 * 2 / 16;
      for (int i = blockIdx.x * 512 + tid; i < n16; i += gridDim.x * 512) z[i] = (u32x4){0u, 0u, 0u, 0u}; }
    bf16_t* H1 = (bf16_t*)(ws + WS_H1);
    f32x4 gv[4];
#pragma unroll
    for (int j = 0; j < 4; ++j) gv[j] = ((const f32x4*)P.g_mix)[lane + 64 * j];
    for (int m0 = gw * 4; m0 < T_; m0 += NGW * 4) {
        f32x4 v[4][4]; float ss[4];
#pragma unroll
        for (int q = 0; q < 4; ++q) { const f32x4* xr = (const f32x4*)(P.x + (size_t)(m0 + q) * D_) + lane;
#pragma unroll
            for (int j = 0; j < 4; ++j) v[q][j] = xr[64 * j]; }
#pragma unroll
        for (int q = 0; q < 4; ++q) { float s = 0.f;
#pragma unroll
            for (int j = 0; j < 4; ++j) s += (v[q][j].x * v[q][j].x + v[q][j].y * v[q][j].y) + (v[q][j].z * v[q][j].z + v[q][j].w * v[q][j].w);
            ss[q] = s; }
#pragma unroll
        for (int o = 1; o < 64; o <<= 1) {
#pragma unroll
            for (int q = 0; q < 4; ++q) ss[q] += __shfl_xor(ss[q], o, 64); }
#pragma unroll
        for (int q = 0; q < 4; ++q) { const float rstd = 1.0f / sqrtf(ss[q] * (1.0f / D_) + RMS_EPS);
            u32x2* o8 = (u32x2*)(H1 + (size_t)(m0 + q) * D_) + lane;
#pragma unroll
            for (int j = 0; j < 4; ++j) { const f32x4 y = v[q][j] * rstd * gv[j]; u32x2 w; w.x = pk2(y.x, y.y); w.y = pk2(y.z, y.w); o8[64 * j] = w; } }
    }
}

struct AttnState { f32x16 o0, o1; float m, l; };
DI void attn_init(AttnState& st) {
#pragma unroll
    for (int i = 0; i < 16; ++i) { st.o0[i] = 0.f; st.o1[i] = 0.f; }
    st.m = -1e29f; st.l = 0.f;
}
DI void stage_kv(LAS unsigned char* kt, const bf16_t* kbase, const bf16_t* vbase, size_t rowstride, int ptid, int nthr, bool with_v) {
    for (int chunk = ptid; chunk < 512; chunk += nthr) {
        const int key = chunk >> 3, dc = chunk & 7;
        const u32x4 kv = *(const u32x4*)(kbase + (size_t)key * rowstride + dc * 8);
        *(LAS u32x4*)(kt + key * KT_STRIDE + dc * 16) = kv;
        if (with_v) {
            const u32x4 vv = *(const u32x4*)(vbase + (size_t)key * rowstride + dc * 8);
            LAS unsigned char* vt = kt + VT_OFF + (dc * 8) * VT_STRIDE + key * 2;
            *(LAS unsigned short*)(vt + 0 * VT_STRIDE) = (unsigned short)(vv.x & 0xffffu); *(LAS unsigned short*)(vt + 1 * VT_STRIDE) = (unsigned short)(vv.x >> 16);
            *(LAS unsigned short*)(vt + 2 * VT_STRIDE) = (unsigned short)(vv.y & 0xffffu); *(LAS unsigned short*)(vt + 3 * VT_STRIDE) = (unsigned short)(vv.y >> 16);
            *(LAS unsigned short*)(vt + 4 * VT_STRIDE) = (unsigned short)(vv.z & 0xffffu); *(LAS unsigned short*)(vt + 5 * VT_STRIDE) = (unsigned short)(vv.z >> 16);
            *(LAS unsigned short*)(vt + 6 * VT_STRIDE) = (unsigned short)(vv.w & 0xffffu); *(LAS unsigned short*)(vt + 7 * VT_STRIDE) = (unsigned short)(vv.w >> 16);
        }
    }
}
template <int NCH> struct KVRegs { u32x4 k[NCH], v[NCH]; };
template <int NCH> DI void kv_load(KVRegs<NCH>& R, const bf16_t* kbase, const bf16_t* vbase, size_t rowstride, int ptid, bool with_v) {
#pragma unroll
    for (int j = 0; j < NCH; ++j) { const int chunk = ptid + j * (512 / NCH), key = chunk >> 3, dc = chunk & 7;
        R.k[j] = *(const u32x4*)(kbase + (size_t)key * rowstride + dc * 8);
        if (with_v) R.v[j] = *(const u32x4*)(vbase + (size_t)key * rowstride + dc * 8); }
}
template <int NCH> DI void kv_store(const KVRegs<NCH>& R, LAS unsigned char* kt, int ptid, bool with_v) {
#pragma unroll
    for (int j = 0; j < NCH; ++j) { const int chunk = ptid + j * (512 / NCH), key = chunk >> 3, dc = chunk & 7;
        *(LAS u32x4*)(kt + key * KT_STRIDE + dc * 16) = R.k[j];
        if (with_v) { const u32x4 vv = R.v[j];
            LAS unsigned char* vt = kt + VT_OFF + (dc * 8) * VT_STRIDE + key * 2;
            *(LAS unsigned short*)(vt + 0 * VT_STRIDE) = (unsigned short)(vv.x & 0xffffu); *(LAS unsigned short*)(vt + 1 * VT_STRIDE) = (unsigned short)(vv.x >> 16);
            *(LAS unsigned short*)(vt + 2 * VT_STRIDE) = (unsigned short)(vv.y & 0xffffu); *(LAS unsigned short*)(vt + 3 * VT_STRIDE) = (unsigned short)(vv.y >> 16);
            *(LAS unsigned short*)(vt + 4 * VT_STRIDE) = (unsigned short)(vv.z & 0xffffu); *(LAS unsigned short*)(vt + 5 * VT_STRIDE) = (unsigned short)(vv.z >> 16);
            *(LAS unsigned short*)(vt + 6 * VT_STRIDE) = (unsigned short)(vv.w & 0xffffu); *(LAS unsigned short*)(vt + 7 * VT_STRIDE) = (unsigned short)(vv.w >> 16); } }
}
template <int NCH, class Body>
DI void run_tiles(LAS unsigned char* buf0, const bf16_t* kb0, const bf16_t* vb0, size_t rowstride, size_t tilestride, unsigned long long mask, int ptid, bool with_v, Body body) {
    if (mask == 0ull) return;
    KVRegs<NCH> R;
    int s = __builtin_ctzll(mask); mask &= mask - 1ull;
    kv_load<NCH>(R, kb0 + (size_t)s * tilestride, vb0 + (size_t)s * tilestride, rowstride, ptid, with_v);
    __syncthreads();
    kv_store<NCH>(R, buf0, ptid, with_v);
    int sn = -1;
    if (mask) { sn = __builtin_ctzll(mask); mask &= mask - 1ull; kv_load<NCH>(R, kb0 + (size_t)sn * tilestride, vb0 + (size_t)sn * tilestride, rowstride, ptid, with_v); }
    __syncthreads();
    int cur = 0;
    for (;;) {
        body(buf0 + cur * KV_REGION, s);
        if (sn < 0) break;
        kv_store<NCH>(R, buf0 + (cur ^ 1) * KV_REGION, ptid, with_v);
        s = sn;
        if (mask) { sn = __builtin_ctzll(mask); mask &= mask - 1ull; kv_load<NCH>(R, kb0 + (size_t)sn * tilestride, vb0 + (size_t)sn * tilestride, rowstride, ptid, with_v); } else sn = -1;
        __syncthreads();
        cur ^= 1;
    }
}
DI void qk_tile(const LAS unsigned char* kt, const bf16x8 (&qf)[4], int r, int h, f32x16& x0, f32x16& x1) {
#pragma unroll
    for (int kk = 0; kk < 4; ++kk) {
        const bf16x8 a0 = *(const LAS bf16x8*)(kt + r * KT_STRIDE + kk * 32 + h * 16);
        const bf16x8 a1 = *(const LAS bf16x8*)(kt + (32 + r) * KT_STRIDE + kk * 32 + h * 16);
        x0 = MFMA32(a0, qf[kk], x0); x1 = MFMA32(a1, qf[kk], x1);
    }
}
DI void bias_init(f32x16& x0, f32x16& x1, float slm, float b0) {
#pragma unroll
    for (int i = 0; i < 16; ++i) { const float c = (float)((i & 3) + 8 * (i >> 2)); x0[i] = __builtin_fmaf(slm, c, b0); x1[i] = __builtin_fmaf(slm, c + 32.0f, b0); }
}
DI bf16x8 pack8(const f32x16& x, int s) {
    u32x4 p; p.x = pk2(x[8 * s + 0], x[8 * s + 1]); p.y = pk2(x[8 * s + 2], x[8 * s + 3]); p.z = pk2(x[8 * s + 4], x[8 * s + 5]); p.w = pk2(x[8 * s + 6], x[8 * s + 7]);
    return __builtin_bit_cast(bf16x8, p);
}
DI bf16x8 scale_q8(bf16x8 q) {
    const u32x4 w = __builtin_bit_cast(u32x4, q); u32x4 o;
    o.x = pk2(bf2f(w.x & 0xffffu) * 0.125f, bf2f(w.x >> 16) * 0.125f); o.y = pk2(bf2f(w.y & 0xffffu) * 0.125f, bf2f(w.y >> 16) * 0.125f);
    o.z = pk2(bf2f(w.z & 0xffffu) * 0.125f, bf2f(w.z >> 16) * 0.125f); o.w = pk2(bf2f(w.w & 0xffffu) * 0.125f, bf2f(w.w >> 16) * 0.125f);
    return __builtin_bit_cast(bf16x8, o);
}
struct NoPost { DI void operator()(const f32x16&, const f32x16&, float) const {} };
template <class VF, class PH = NoPost>
DI void attn_tile_dyn(bool MASKED, const LAS unsigned char* kt, const bf16x8 (&qf)[4], AttnState& st, int r, int h, float slm, float b0, VF valid, PH post = PH()) {
    f32x16 x0, x1;
    bias_init(x0, x1, slm, b0);
    qk_tile(kt, qf, r, h, x0, x1);
    if (MASKED) {
#pragma unroll
        for (int i = 0; i < 16; ++i) { const int k0 = crow(i, h); x0[i] = valid(k0) ? x0[i] : -1e30f; x1[i] = valid(32 + k0) ? x1[i] : -1e30f; }
    }
    float mxa = fmaxf(x0[0], x1[0]), mxb = fmaxf(x0[1], x1[1]);
#pragma unroll
    for (int i = 2; i < 16; i += 2) { mxa = fmaxf(fmaxf(mxa, x0[i]), x1[i]); mxb = fmaxf(fmaxf(mxb, x0[i + 1]), x1[i + 1]); }
    float mx = fmaxf(fmaxf(st.m, mxa), mxb);
    { const unsigned mu = __float_as_uint(mx); const auto sw = __builtin_amdgcn_permlane32_swap(mu, mu, false, false);
      mx = fmaxf(__uint_as_float(sw[0]), __uint_as_float(sw[1])); }
    const float alpha = fexp2((st.m - mx) * LOG2E); st.m = mx;
    const float nm = -mx * LOG2E;
    float ls = 0.f;
#pragma unroll
    for (int i = 0; i < 16; ++i) { x0[i] = fexp2(__builtin_fmaf(x0[i], LOG2E, nm)); x1[i] = fexp2(__builtin_fmaf(x1[i], LOG2E, nm)); ls += x0[i] + x1[i]; }
    st.l = st.l * alpha + ls;
    post(x0, x1, mx);
#pragma unroll
    for (int i = 0; i < 16; ++i) { st.o0[i] *= alpha; st.o1[i] *= alpha; }
    const LAS unsigned char* vt = kt + VT_OFF;
#pragma unroll
    for (int kh = 0; kh < 2; ++kh)
#pragma unroll
        for (int s = 0; s < 2; ++s) {
            const bf16x8 pb = kh ? pack8(x1, s) : pack8(x0, s);
            const int keyoff = (32 * kh + 16 * s + 4 * h) * 2;
            { const LAS unsigned char* vp = vt + r * VT_STRIDE + keyoff; const s16x4 lo = *(const LAS s16x4*)vp, hi = *(const LAS s16x4*)(vp + 16);
              const bf16x8 pa = __builtin_shufflevector(lo, hi, 0, 1, 2, 3, 4, 5, 6, 7); st.o0 = MFMA32(pa, pb, st.o0); }
            { const LAS unsigned char* vp = vt + (32 + r) * VT_STRIDE + keyoff; const s16x4 lo = *(const LAS s16x4*)vp, hi = *(const LAS s16x4*)(vp + 16);
              const bf16x8 pa = __builtin_shufflevector(lo, hi, 0, 1, 2, 3, 4, 5, 6, 7); st.o1 = MFMA32(pa, pb, st.o1); }
        }
}
DI void cmp_unit(const Params& P, LAS unsigned char* lds, int u) {
    int tid = threadIdx.x; asm volatile("" : "+v"(tid));
    const int w = __builtin_amdgcn_readfirstlane(tid >> 6), lane = tid & 63, r = lane & 31, h = lane >> 5;
    const int which = u >> 6, b = (u >> 4) & 3, g = (u >> 3) & 1, ct = u & 7;
    unsigned char* ws = P.ws;
    const bf16_t* src = (const bf16_t*)(ws + WS_PJKV) + which * 128 + g * 64;
    const float* pe = which ? P.pe_v : P.pe_k;
    const bf16_t* W1t = (const bf16_t*)(ws + (which ? WS_W1V : WS_W1K));
    const bf16_t* W2t = (const bf16_t*)(ws + (which ? WS_W2V : WS_W2K));
    bf16_t* outp = (bf16_t*)(ws + (which ? WS_VC : WS_KC));
    const int cbase = 32 * ct; int c = cbase + r; if (c > 254) c = 254;
    f32x16 acc[4];
#pragma unroll
    for (int nt = 0; nt < 4; ++nt)
#pragma unroll
        for (int i = 0; i < 16; ++i) acc[nt][i] = 0.f;
#pragma unroll 1
    for (int jj = 0; jj < 4; ++jj) {
        const int j = 4 * w + jj; const bf16_t* rowp = src + (size_t)(b * S_ + 16 * c + j) * 768;
#pragma unroll
        for (int kk = 0; kk < 4; ++kk) {
            const int d0 = 16 * kk + 8 * h;
            const u32x4 raw = *(const u32x4*)(rowp + d0);
            const f32x4 p0 = *(const f32x4*)(pe + j * 64 + d0), p1 = *(const f32x4*)(pe + j * 64 + d0 + 4);
            u32x4 av; av.x = pk2(bf2f(raw.x & 0xffffu) + p0[0], bf2f(raw.x >> 16) + p0[1]); av.y = pk2(bf2f(raw.y & 0xffffu) + p0[2], bf2f(raw.y >> 16) + p0[3]);
            av.z = pk2(bf2f(raw.z & 0xffffu) + p1[0], bf2f(raw.z >> 16) + p1[1]); av.w = pk2(bf2f(raw.w & 0xffffu) + p1[2], bf2f(raw.w >> 16) + p1[3]);
            const bf16x8 a = __builtin_bit_cast(bf16x8, av);
#pragma unroll
            for (int nt = 0; nt < 4; ++nt) { const bf16x8 bb = *(const bf16x8*)(W1t + (size_t)(32 * nt + r) * 2048 + j * 64 + d0); acc[nt] = MFMA32(a, bb, acc[nt]); }
        }
    }
    __syncthreads();
    LAS float* part = (LAS float*)lds;
#pragma unroll
    for (int nt = 0; nt < 4; ++nt)
#pragma unroll
        for (int i = 0; i < 16; ++i) part[(w * 32 + crow(i, h)) * 128 + 32 * nt + r] = acc[nt][i];
    __syncthreads();
    LAS unsigned char* hidb = lds + HIDB_OFF;
#pragma unroll
    for (int e = 0; e < 8; ++e) { const int o = tid + 512 * e; float s = 0.f;
#pragma unroll
        for (int ww = 0; ww < 8; ++ww) s += part[ww * 4096 + o];
        const float gl = gelu_tanh(s); const int cl = o >> 7, n = o & 127;
        *(LAS unsigned short*)(hidb + cl * HIDB_STRIDE + n * 2) = (unsigned short)(pk2(gl, 0.f) & 0xffffu); }
    __syncthreads();
    if (w < 2) {
        f32x16 a2;
#pragma unroll
        for (int i = 0; i < 16; ++i) a2[i] = 0.f;
#pragma unroll
        for (int ks = 0; ks < 8; ++ks) { const bf16x8 a = *(const LAS bf16x8*)(hidb + r * HIDB_STRIDE + (16 * ks + 8 * h) * 2);
            const bf16x8 bb = *(const bf16x8*)(W2t + (size_t)(32 * w + r) * 128 + 16 * ks + 8 * h); a2 = MFMA32(a, bb, a2); }
#pragma unroll
        for (int i = 0; i < 16; ++i) outp[((size_t)(b * 2 + g) * 256 + cbase + crow(i, h)) * 64 + 32 * w + r] = (bf16_t)(pk2(a2[i], 0.f) & 0xffffu);
    }
    __syncthreads();
}

DI void dil_unit(const Params& P, LAS unsigned char* lds, int b, int g, int u64) {
    int tid = threadIdx.x; asm volatile("" : "+v"(tid));
    const int w = __builtin_amdgcn_readfirstlane(tid >> 6), lane = tid & 63, r = lane & 31, h = lane >> 5;
    const int hh = w >> 1, qh = w & 1;
    const int rd = (g == 0) ? 1 : (g == 1 ? 4 : 16), ntr = 64 / rd, c = u64 / ntr, ut = u64 % ntr;
    const int uq = 64 * ut + 32 * qh + r, tq = c + rd * uq; const size_t trow = (size_t)b * S_ + tq;
    const int head = g * 4 + hh;
    const float slm = fexp2(-(float)(head + 1) * (2.0f / 3.0f)) * (float)rd;
    unsigned char* ws = P.ws;
    const bf16_t* PJB = (const bf16_t*)(ws + WS_PJB);
    bf16x8 qf[4];
#pragma unroll
    for (int kk = 0; kk < 4; ++kk) qf[kk] = scale_q8(*(const bf16x8*)(PJB + trow * 2304 + g * 256 + hh * 64 + 16 * kk + 8 * h));
    AttnState st; attn_init(st);
    const int kt0 = ut >= 2 ? ut - 2 : 0;
    const unsigned long long tmask = ((2ull << ut) - 1ull) & ~((1ull << kt0) - 1ull);
    const bf16_t* kb0 = PJB + ((size_t)b * S_ + c) * 2304 + 768 + g * 256 + hh * 64;
    run_tiles<4>(lds + hh * 2 * KV_REGION, kb0, kb0 + 768, (size_t)rd * 2304, (size_t)rd * 64 * 2304, tmask, tid & 127, true,
        [&](const LAS unsigned char* kt, int t) { const int ubase = uq - 64 * t;
            attn_tile_dyn(t == ut || t + 2 == ut, kt, qf, st, r, h, slm, slm * (float)(4 * h - ubase), [=](int key) { const int du = ubase - key; return du >= 0 && du <= 128; }); });
    const float l = st.l + __shfl_xor(st.l, 32, 64), inv = 1.0f / l;
    bf16_t* od = (bf16_t*)(ws + WS_OD) + ((size_t)g * T_ + trow) * 256 + hh * 64;
#pragma unroll
    for (int gq = 0; gq < 4; ++gq) {
        u32x2 w0; w0.x = pk2(st.o0[4 * gq] * inv, st.o0[4 * gq + 1] * inv); w0.y = pk2(st.o0[4 * gq + 2] * inv, st.o0[4 * gq + 3] * inv);
        *(u32x2*)(od + 8 * gq + 4 * h) = w0;
        u32x2 w1; w1.x = pk2(st.o1[4 * gq] * inv, st.o1[4 * gq + 1] * inv); w1.y = pk2(st.o1[4 * gq + 2] * inv, st.o1[4 * gq + 3] * inv);
        *(u32x2*)(od + 32 + 8 * gq + 4 * h) = w1;
    }
    if (h == 0) ((float*)(ws + WS_LSE))[((size_t)g * T_ + trow) * 4 + hh] = st.m + __log2f(l) * LN2;
}

DI void nsa_unit(const Params& P, LAS unsigned char* lds, int b, int g, int i) {
    int tid = threadIdx.x; asm volatile("" : "+v"(tid));
    const int w = __builtin_amdgcn_readfirstlane(tid >> 6), lane = tid & 63, r = lane & 31, h = lane >> 5;
    const int rr = w >> 1, qh = w & 1, head = g * 4 + rr;
    const int ql = 32 * qh + r, tq = 64 * i + ql; const size_t trow = (size_t)b * S_ + tq;
    const float slope = fexp2(-(float)(head + 1));
    unsigned char* ws = P.ws;
    const bf16_t* PJQ = (const bf16_t*)(ws + WS_PJQ); const bf16_t* PJKV = (const bf16_t*)(ws + WS_PJKV); const bf16_t* PJG = (const bf16_t*)(ws + WS_PJG);
    bf16x8 qf[4];
#pragma unroll
    for (int kk = 0; kk < 4; ++kk) qf[kk] = scale_q8(*(const bf16x8*)(PJQ + trow * 512 + head * 64 + 16 * kk + 8 * h));
    const float g0 = sigmoidf_(bf2f(PJG[trow * 256 + head * 3 + 0])), g1 = sigmoidf_(bf2f(PJG[trow * 256 + head * 3 + 1])), g2 = sigmoidf_(bf2f(PJG[trow * 256 + head * 3 + 2]));
    LAS unsigned char* kt = lds;
    f32x16 oa0, oa1;
    const int ncmp = 4 * i + 3, ntc = (ncmp + 63) >> 6;
    const bf16_t* KC = (const bf16_t*)(ws + WS_KC) + (size_t)(b * 2 + g) * 256 * 64;
    const bf16_t* VC = (const bf16_t*)(ws + WS_VC) + (size_t)(b * 2 + g) * 256 * 64;
    AttnState st; attn_init(st);
    const unsigned long long cmask = (1ull << ntc) - 1ull;
    const bool need_imp = i > 15;
    LAS float* imp = (LAS float*)(lds + IMP_OFF) + (rr * 64 + ql) * IMP_QS;
    LAS float* mxt = (LAS float*)(lds + MXT_OFF) + (rr * 64 + ql) * 4;
    LAS float* spl = (LAS float*)(lds + SPL_OFF) + (rr * 64 + ql) * 4;
    run_tiles<1>(kt, KC, VC, 64, 64 * 64, cmask, tid, true, [&](const LAS unsigned char* kb, int t) {
        const int dbase = tq - 31 - 1024 * t;
        attn_tile_dyn(64 * i - 31 - 1024 * t < 1008, kb, qf, st, r, h, 16.0f * slope, slope * (float)(64 * h - dbase), [=](int key) { return dbase - 16 * key >= 0; },
            [&](const f32x16& p0, const f32x16& p1, float mx) {
                if (!need_imp) return;
                float carry = 0.f;
#pragma unroll
                for (int kh = 0; kh < 2; ++kh) {
                    float mainv[4], sp[4], recv[4];
#pragma unroll
                    for (int gq = 0; gq < 4; ++gq) { const float a = kh ? p1[4 * gq] : p0[4 * gq], bq = kh ? p1[4 * gq + 1] : p0[4 * gq + 1], c = kh ? p1[4 * gq + 2] : p0[4 * gq + 2], d = kh ? p1[4 * gq + 3] : p0[4 * gq + 3];
                        mainv[gq] = (a + bq) + (c + 0.5f * d); sp[gq] = 0.5f * d; }
#pragma unroll
                    for (int gq = 0; gq < 4; ++gq) recv[gq] = __shfl_xor(sp[gq], 32, 64);
#pragma unroll
                    for (int gq = 0; gq < 4; ++gq) { const float add = h ? recv[gq] : (gq ? recv[gq > 0 ? gq - 1 : 0] : carry);
                        imp[16 * t + 8 * kh + 2 * gq + h] = mainv[gq] + add; }
                    carry = recv[3];
                }
                if (h == 0) { mxt[t] = mx; if (t < 3) spl[t + 1] = carry; }
            }); });
    const float mc = st.m; float lc = st.l + __shfl_xor(st.l, 32, 64); const float invc = lc > 0.f ? 1.0f / lc : 0.f;
    { const float sgc = g0 * invc;
#pragma unroll
      for (int e = 0; e < 16; ++e) { oa0[e] = st.o0[e] * sgc; oa1[e] = st.o1[e] * sgc; } }
    if (need_imp && h == 0) {
#pragma unroll 1
        for (int t = 0; t < ntc; ++t) mxt[t] = fexp2((mxt[t] - mc) * LOG2E) * invc;
    }
    __syncthreads();
    {
        LAS unsigned long long* selm = (LAS unsigned long long*)(lds + SEL_OFF);
        LAS unsigned long long* uni = (LAS unsigned long long*)(lds + UNI_OFF);
        unsigned long long un = 0ull;
        if (i <= 15) { const unsigned long long m = (2ull << i) - 1ull; if (lane < 8) selm[8 * w + lane] = m; un = m; }
        else {
            const LAS float* impb = (const LAS float*)(lds + IMP_OFF);
            const LAS float* fac = (const LAS float*)(lds + MXT_OFF); const LAS float* spb = (const LAS float*)(lds + SPL_OFF);
            const int tl = lane >> 4; const bool head16 = (lane & 15) == 0 && lane > 0;
            const bool cand = (lane >= 1) && (lane <= i - 1);
#pragma unroll 1
            for (int qq = 0; qq < 8; qq += 2) {
                float v[2];
#pragma unroll
                for (int z = 0; z < 2; ++z) { const int q = 8 * w + qq + z; float acc = 0.f;
#pragma unroll
                    for (int hd = 0; hd < 4; ++hd) { const int fo = (hd * 64 + q) * 4;
                        acc += impb[(hd * 64 + q) * IMP_QS + lane] * fac[fo + tl];
                        if (head16) acc += spb[fo + tl] * fac[fo + tl - 1]; }
                    v[z] = acc; }
                const unsigned kb0 = __float_as_uint(v[0]), kb1 = __float_as_uint(v[1]);
                unsigned T0 = 0u, T1 = 0u;
#pragma unroll 1
                for (int bb = 30; bb >= 0; --bb) { const unsigned Tn0 = T0 | (1u << bb), Tn1 = T1 | (1u << bb);
                    const int c0 = __popcll(__ballot(cand && kb0 >= Tn0)), c1 = __popcll(__ballot(cand && kb1 >= Tn1));
                    if (c0 >= 14) T0 = Tn0; if (c1 >= 14) T1 = Tn1; }
#pragma unroll
                for (int z = 0; z < 2; ++z) { const unsigned kb = z ? kb1 : kb0, T = z ? T1 : T0;
                    const unsigned long long gtm = __ballot(cand && kb > T), eqm = __ballot(cand && kb == T);
                    const int need = 14 - __popcll(gtm);
                    const bool seleq = ((eqm >> lane) & 1ull) && (__popcll(eqm & ((1ull << lane) - 1ull)) < need);
                    const bool sel = (lane == 0) || (lane == i) || (cand && kb > T) || seleq;
                    const unsigned long long m = __ballot(sel);
                    if (lane == 0) selm[8 * w + qq + z] = m;
                    un |= m; } }
        }
        if (lane == 0) uni[w] = un;
    }
    __syncthreads();
    unsigned long long myq, un;
    { const LAS unsigned long long* selm = (const LAS unsigned long long*)(lds + SEL_OFF); const LAS unsigned long long* uni = (const LAS unsigned long long*)(lds + UNI_OFF);
      myq = selm[ql]; un = ((uni[0] | uni[1]) | (uni[2] | uni[3])) | ((uni[4] | uni[5]) | (uni[6] | uni[7])); }
    attn_init(st);
    { const bf16_t* kb0 = PJKV + (size_t)b * S_ * 768 + 2 * 128 + g * 64;
      run_tiles<1>(kt, kb0, kb0 + 128, 768, 64 * 768, un & ((2ull << i) - 1ull), tid, true, [&](const LAS unsigned char* kb, int s) {
        const bool selq = (myq >> s) & 1ull; const int dbase = tq - 64 * s;
        attn_tile_dyn(s == i, kb, qf, st, r, h, slope, selq ? slope * (float)(4 * h - dbase) : -1e30f, [=](int key) { return dbase - key >= 0; }); }); }
    { const float l = st.l + __shfl_xor(st.l, 32, 64); const float sg = l > 0.f ? g1 / l : 0.f;
#pragma unroll
      for (int e = 0; e < 16; ++e) { oa0[e] += st.o0[e] * sg; oa1[e] += st.o1[e] * sg; } }
    attn_init(st);
    { const bf16_t* kb0 = PJKV + (size_t)b * S_ * 768 + 4 * 128 + g * 64; const int s0 = i >= 8 ? i - 8 : 0;
      run_tiles<1>(kt, kb0, kb0 + 128, 768, 64 * 768, ((2ull << i) - 1ull) & ~((1ull << s0) - 1ull), tid, true, [&](const LAS unsigned char* kb, int s) {
        const int dbase = tq - 64 * s;
        attn_tile_dyn(s == i || s + 8 == i, kb, qf, st, r, h, slope, slope * (float)(4 * h - dbase), [=](int key) { const int d = dbase - key; return d >= 0 && d < 512; }); }); }
    { const float l = st.l + __shfl_xor(st.l, 32, 64); const float sg = l > 0.f ? g2 / l : 0.f;
#pragma unroll
      for (int e = 0; e < 16; ++e) { oa0[e] += st.o0[e] * sg; oa1[e] += st.o1[e] * sg; } }
    bf16_t* oab = (bf16_t*)P.out + trow * 768 + head * 64;
#pragma unroll
    for (int gq = 0; gq < 4; ++gq) {
        u32x2 w0; w0.x = pk2(oa0[4 * gq], oa0[4 * gq + 1]); w0.y = pk2(oa0[4 * gq + 2], oa0[4 * gq + 3]); *(u32x2*)(oab + 8 * gq + 4 * h) = w0;
        u32x2 w1; w1.x = pk2(oa1[4 * gq], oa1[4 * gq + 1]); w1.y = pk2(oa1[4 * gq + 2], oa1[4 * gq + 3]); *(u32x2*)(oab + 32 + 8 * gq + 4 * h) = w1;
    }
    __syncthreads();
}

#define XB_TMO      128
#define XB_XCNT(j)  (256  + 64 * (j))
#define XB_XSUB(j)  (1280 + 64 * (j))
#define XB_XGEN(j)  (2304 + 64 * (j))
#define XB_TOP      3328
#define XB_TOPGEN   3392
#define XCD_BAR_WORDS 3456
#define XB_SPIN_CAP (1u << 18)
DI unsigned xb_ld(unsigned* p)              { return __hip_atomic_load(p, __ATOMIC_RELAXED, __HIP_MEMORY_SCOPE_AGENT); }
DI unsigned xb_add(unsigned* p, unsigned v) { return __hip_atomic_fetch_add(p, v, __ATOMIC_RELAXED, __HIP_MEMORY_SCOPE_AGENT); }
DI unsigned xb_xcc_id() { return (unsigned)__builtin_amdgcn_s_getreg((3 << 11) | 20) & 0xFu; }
#define XB_SPIN(cond, bar) do { unsigned _sp = 0; while (cond) { __builtin_amdgcn_s_sleep(1); \
    if ((++_sp & 255u) == 0u) { if (xb_ld(&(bar)[XB_TMO])) break; if (_sp > XB_SPIN_CAP) { atomicAdd(&(bar)[XB_TMO], 1u); break; } } } } while (0)
struct XcdBarrier { unsigned* bar; unsigned x; volatile LAS unsigned* st; };
DI void xcd_barrier_complete(unsigned* bar, unsigned x, unsigned& nloc, unsigned& nx) {
    const unsigned G = gridDim.x * gridDim.y * gridDim.z;
    unsigned sum, cnt, mine, sp = 0u;
    for (;;) {
        sum = 0u; cnt = 0u; mine = 0u;
#pragma unroll
        for (unsigned j = 0; j < 16; ++j) { const unsigned c = xb_ld(&bar[XB_XCNT(j)]); sum += c; cnt += (c > 0u) ? 1u : 0u; mine = (j == x) ? c : mine; }
        if (sum == G) break;
        __builtin_amdgcn_s_sleep(1);
        if ((++sp & 255u) == 0u) { if (xb_ld(&bar[XB_TMO])) break; if (sp > XB_SPIN_CAP) { atomicAdd(&bar[XB_TMO], 1u); break; } }
    }
    nloc = mine > 0u ? mine : 1u; nx = cnt > 0u ? cnt : 1u;
}
__device__ __attribute__((noinline)) void xcd_barrier(unsigned* bar, volatile LAS unsigned* st) {
    asm volatile("s_waitcnt vmcnt(0)" ::: "memory");
    __syncthreads();
    if (threadIdx.x == 0) {
        const unsigned x = xb_xcc_id();
        __builtin_amdgcn_s_waitcnt(0);
        unsigned nloc = st[0], nx = st[1];
        if (nloc == 0u) { xcd_barrier_complete(bar, x, nloc, nx); st[0] = nloc; st[1] = nx; }
        const unsigned old = xb_add(&bar[XB_XSUB(x)], 1u);
        const unsigned gen = old / nloc;
        if (old + 1u == (gen + 1u) * nloc) {
            __builtin_amdgcn_fence(__ATOMIC_RELEASE, "agent");
            asm volatile("s_waitcnt vmcnt(0)" ::: "memory");
            const unsigned og = xb_add(&bar[XB_TOP], 1u);
            const unsigned tg = og / nx;
            if (og + 1u == (tg + 1u) * nx) xb_add(&bar[XB_TOPGEN], 1u);
            else XB_SPIN(xb_ld(&bar[XB_TOPGEN]) == tg, bar);
            __builtin_amdgcn_fence(__ATOMIC_ACQUIRE, "agent");
            xb_add(&bar[XB_XGEN(x)], 1u);
            asm volatile("s_waitcnt vmcnt(0)" ::: "memory");
        } else {
            XB_SPIN(xb_ld(&bar[XB_XGEN(x)]) == gen, bar);
            __builtin_amdgcn_fence(__ATOMIC_ACQUIRE, "agent");
            asm volatile("s_waitcnt vmcnt(0)" ::: "memory");
        }
    }
    __syncthreads();
}

DI void ph1(const Params& P, LAS unsigned char* lds, int G, int bid) {
    unsigned char* ws = P.ws;
    pg8::Gemm g{(const bf16_t*)(ws + WS_H1), (const bf16_t*)(ws + WS_WIN), T_, NIN, 1024, 1024, 128}; pg8::StaticOrder S; S.init(T_, NIN, G, bid);
    pg8::EpiProj E{ws}; pg8::gemm_phase(lds, g, S, E);
}
DI void ph2(const Params& P, LAS unsigned char* lds, int G, int bid) {
    if (G == 256) {
        const int x = bid & 7, k = bid >> 3;
        if (k < 16) { cmp_unit(P, lds, bid);
            for (int j = 0; j < 2; ++j) { const int v = (8 + (x >> 1)) * 64 + (x & 1) * 32 + k * 2 + j; dil_unit(P, lds, v / 192, (v / 64) % 3, v % 64); } }
        else for (int j = 0; j < 4; ++j) { const int v = x * 64 + (k - 16) * 4 + j; dil_unit(P, lds, v / 192, (v / 64) % 3, v % 64); }
    } else
    for (int u = bid; u < 128 + 768; u += G) {
        if (u < 128) cmp_unit(P, lds, u);
        else { const int v = u - 128; dil_unit(P, lds, v / 192, (v / 64) % 3, v % 64); }
    }
    __syncthreads();
}
DI void ph3(const Params& P, LAS unsigned char* lds, int G, int bid) {
    unsigned char* ws = P.ws; const int tid = threadIdx.x;
    for (int p0 = bid; p0 < 256; p0 += G) { const int p = (G == 256) ? ((p0 & 7) * 32 + (p0 >> 3)) : p0;
        const int b = p >> 6, g = (p >> 5) & 1, ip = p & 31;
        nsa_unit(P, lds, b, g, 63 - ip); nsa_unit(P, lds, b, g, ip);
        if (DUP_PHASE == 33) { nsa_unit(P, lds, b, g, 63 - ip); nsa_unit(P, lds, b, g, ip); } }
    const bf16_t* OD = (const bf16_t*)(ws + WS_OD); const float* LSE = (const float*)(ws + WS_LSE); bf16_t* oab = (bf16_t*)P.out;
    for (int it = bid * 512 + tid; it < T_ * 32; it += G * 512) { const int t = it >> 5, hh = (it >> 3) & 3, dc = it & 7;
        const float l0 = LSE[(size_t)t * 4 + hh], l1 = LSE[((size_t)T_ + t) * 4 + hh], l2 = LSE[((size_t)2 * T_ + t) * 4 + hh];
        const float mx = fmaxf(l0, fmaxf(l1, l2)); const float e0 = __expf(l0 - mx), e1 = __expf(l1 - mx), e2 = __expf(l2 - mx); const float inv = 1.0f / (e0 + e1 + e2);
        f32x4 a0, a1, b0, b1, c0, c1; pg8::load8(OD + (size_t)t * 256 + hh * 64 + dc * 8, a0, a1); pg8::load8(OD + ((size_t)T_ + t) * 256 + hh * 64 + dc * 8, b0, b1);
        pg8::load8(OD + ((size_t)2 * T_ + t) * 256 + hh * 64 + dc * 8, c0, c1);
        const float w0 = e0 * inv, w1 = e1 * inv, w2 = e2 * inv;
        pg8::store8(oab + (size_t)t * 768 + 512 + hh * 64 + dc * 8, a0 * w0 + b0 * w1 + c0 * w2, a1 * w0 + b1 * w1 + c1 * w2); }
}
DI void ph4(const Params& P, LAS unsigned char* lds, int G, int bid) {
    unsigned char* ws = P.ws;
    pg8::Gemm g{(const bf16_t*)P.out, (const bf16_t*)(ws + WS_WPN), T_, 1024, 768, 768, 128}; pg8::StaticOrder S; S.init(T_, 1024, G, bid);
    pg8::EpiMerge E{(const bf16_t*)(ws + WS_PJM), (bf16_t*)(ws + WS_MIX)}; pg8::gemm_phase<pg8::EpiMerge, 6>(lds, g, S, E);
}
DI void ph5(const Params& P, LAS unsigned char* lds, int G, int bid) {
    unsigned char* ws = P.ws;
    pg8::Gemm g{(const bf16_t*)(ws + WS_MIX), (const bf16_t*)(ws + WS_WOUT), T_, 1024, 1024, 1024, 128}; pg8::StaticOrder S; S.init(T_, 1024, G, bid);
    pg8::EpiResid<1> E{P.x, P.out, (bf16_t*)(ws + WS_A2), P.g_ffn, (float*)(ws + WS_SSQ2)}; pg8::gemm_phase(lds, g, S, E);
}
DI void ph6(const Params& P, LAS unsigned char* lds, int G, int bid) {
    unsigned char* ws = P.ws;
    pg8::Gemm g{(const bf16_t*)(ws + WS_A2), (const bf16_t*)(ws + WS_WUP), T_, NUP, 1024, 1024, 128}; pg8::StaticOrder S; S.init(T_, NUP, G, bid);
    { LAS float* rsall = (LAS float*)(lds + HIDB_OFF + 8192); const float* ssq = (const float*)(ws + WS_SSQ2); pg8::Unit u;
      for (int i = 0; i < 6 && S.next(i, u); ++i) { const int t = threadIdx.x;
          if (t < 256) { const f32x4* sp = (const f32x4*)(ssq + (size_t)(u.pm * 256 + t) * 16); const f32x4 st = (sp[0] + sp[1]) + (sp[2] + sp[3]);
              rsall[i * 256 + t] = __builtin_amdgcn_rsqf(((st[0] + st[1]) + (st[2] + st[3])) * (1.0f / 1024.0f) + RMS_EPS); } }
      __syncthreads(); }
    pg8::EpiUpConv E{(const float*)(ws + WS_SSQ2), (bf16_t*)(ws + WS_ACT), P.conv_w, P.conv_b, (float*)(ws + WS_ULAST), (float*)(ws + WS_UFIRST), (float*)(ws + WS_GFIRST), lds + HIDB_OFF};
    if (DUP_PHASE == 60) { pg8::EpiNull E0; pg8::gemm_phase(lds, g, S, E0); }
    pg8::gemm_phase(lds, g, S, E);
}
DI void ph8(const Params& P, LAS unsigned char* lds, int G, int bid) {
    unsigned char* ws = P.ws; const int tid = threadIdx.x;
    pg8::StaticOrder S; S.init(T_, 1024, G, bid);
    { const float* ulast = (const float*)(ws + WS_ULAST); const float* ufirst = (const float*)(ws + WS_UFIRST); const float* gfirst = (const float*)(ws + WS_GFIRST); bf16_t* act = (bf16_t*)(ws + WS_ACT);
      pg8::Unit u;
      for (int i = 0; S.next(i, u); ++i) { const int pm = u.pm; const bool first = (pm & 15) == 0;
          for (int c = tid; c < DFF; c += 512) {
              const float ul0 = first ? 0.f : ulast[((size_t)(pm - 1) * 2 + 0) * DFF + c], ul1 = first ? 0.f : ulast[((size_t)(pm - 1) * 2 + 1) * DFF + c];
              const float u0 = ufirst[((size_t)pm * 2 + 0) * DFF + c], u1 = ufirst[((size_t)pm * 2 + 1) * DFF + c];
              const float g0 = gfirst[((size_t)pm * 2 + 0) * DFF + c], g1 = gfirst[((size_t)pm * 2 + 1) * DFF + c];
              const float w0 = P.conv_w[c], w1 = P.conv_w[DFF + c], w2 = P.conv_w[2 * DFF + c], cb = P.conv_b[c];
              const float a0 = gelu_tanh(cb + w0 * ul0 + w1 * ul1 + w2 * u0) * g0, a1 = gelu_tanh(cb + w0 * ul1 + w1 * u0 + w2 * u1) * g1;
              act[(size_t)(pm * 256) * DFF + c] = (bf16_t)(pk2(a0, 0.f) & 0xffffu); act[(size_t)(pm * 256 + 1) * DFF + c] = (bf16_t)(pk2(a1, 0.f) & 0xffffu); } }
      asm volatile("s_waitcnt vmcnt(0)" ::: "memory"); __syncthreads(); }
    pg8::Gemm g{(const bf16_t*)(ws + WS_ACT), (const bf16_t*)(ws + WS_WDN), T_, 1024, DFF, DFF, 128};
    if (DUP_PHASE == 8) { pg8::EpiNull E0; pg8::gemm_phase(lds, g, S, E0); }
    if (G == 256) { pg8::EpiFinal E{P.out, P.out, P.g_final, (float*)(ws + WS_SSQ3), (unsigned*)(ws + WS_CTL) + 3520, lds + HIDB_OFF}; pg8::gemm_phase(lds, g, S, E); }
    else { pg8::EpiResid<0> E{P.out, P.out, nullptr, nullptr, (float*)(ws + WS_SSQ3)}; pg8::gemm_phase(lds, g, S, E); }
}
DI void ph9(const Params& P, LAS unsigned char* lds, int G, int bid) {
    unsigned char* ws = P.ws; const int tid = threadIdx.x;
    const int lane = tid & 63, gw = bid * 8 + (tid >> 6), NGW = G * 8; const float* ssq = (const float*)(ws + WS_SSQ3);
    f32x4 gv[4];
#pragma unroll
    for (int j = 0; j < 4; ++j) gv[j] = ((const f32x4*)P.g_final)[lane + 64 * j];
    for (int m = gw; m < T_; m += NGW) {
        const f32x4* sp = (const f32x4*)(ssq + (size_t)m * 16); const f32x4 st = (sp[0] + sp[1]) + (sp[2] + sp[3]);
        const float rstd = 1.0f / sqrtf(((st[0] + st[1]) + (st[2] + st[3])) * (1.0f / 1024.0f) + RMS_EPS);
        f32x4* xr = (f32x4*)(P.out + (size_t)m * D_) + lane;
#pragma unroll
        for (int j = 0; j < 4; ++j) xr[64 * j] = xr[64 * j] * rstd * gv[j];
    }
}

__device__ __attribute__((noinline)) void grid_sync_call() { cg::this_grid().sync(); }
__global__ void __launch_bounds__(512, 2) fwd_megakernel(Params P) {
    extern __shared__ __attribute__((aligned(16))) unsigned char lds_raw[];
    LAS unsigned char* lds = (LAS unsigned char*)lds_raw;
    const int G = gridDim.x, bid = blockIdx.x;
    const int lo = P.ph_lo, hi = P.ph_hi;
    unsigned* barw = (unsigned*)(P.ws + WS_CTL); volatile LAS unsigned* stw = (volatile LAS unsigned*)(lds + ST_OFF);
    if (threadIdx.x < 4) stw[threadIdx.x] = 0u;
    if (threadIdx.x == 0) (void)xb_add(&barw[XB_XCNT(xb_xcc_id())], 1u);
    if (lo < 0) grid_sync_call();
    __syncthreads();
#define IN(k) (lo <= (k) && (k) < hi)
#define SEAM(k) do { if (IN(k) && hi > (k) + 1) xcd_barrier(barw, stw); } while (0)
#ifndef PROBE_SPAN
#define PROBE_SPAN -1
#endif
#define TS0(k) do { if (PROBE_SPAN == (k) && bid == 0 && threadIdx.x == 0) stw[2] = (unsigned)__builtin_amdgcn_s_memrealtime(); } while (0)
#define TS1(k) do { if (PROBE_SPAN == (k) && bid == 0 && threadIdx.x == 0) stw[3] = (unsigned)__builtin_amdgcn_s_memrealtime(); } while (0)
#define PHASE(k, fn) do { TS0(k); if (IN(k)) { fn(P, lds, G, bid); if (DUP_PHASE == (k)) fn(P, lds, G, bid); } SEAM(k); TS1(k); } while (0)
    TS0(0);
    if (IN(0)) { p0_prologue(P, lds); __syncthreads(); if (DUP_PHASE == 0) { p0_prologue(P, lds); __syncthreads(); } }
    SEAM(0); TS1(0);
    PHASE(1, ph1); PHASE(2, ph2); PHASE(3, ph3); PHASE(4, ph4); PHASE(5, ph5); PHASE(6, ph6);
    TS0(8);
    if (IN(8)) ph8(P, lds, G, bid);
    if (G != 256) { SEAM(8); } TS1(8);
    TS0(9);
    if (IN(9) && G != 256) ph9(P, lds, G, bid);
    TS1(9);
    if (PROBE_SPAN >= 0 && bid == 0 && threadIdx.x == 0) { const unsigned t = (unsigned)__builtin_amdgcn_s_memrealtime(), d = stw[3] - stw[2]; while ((unsigned)__builtin_amdgcn_s_memrealtime() - t < d) __builtin_amdgcn_s_sleep(8); }
#undef TS0
#undef TS1
#undef IN
#undef SEAM
#undef PHASE
}

extern "C" void kernel_launch(void* const* d_in, const int* in_sizes, int n_in, void* d_out, int out_size, void* d_ws, size_t ws_size, hipStream_t stream) {
    static int grid = 0;
    if (grid == 0) {
        if (n_in != 18 || ws_size < WS_END) { fprintf(stderr, "kernel_launch: unexpected inputs (n_in %d, ws %zu)\n", n_in, ws_size); grid = -1; return; }
        int dev = 0, cus = 0, per_cu = 0;
        (void)hipGetDevice(&dev); (void)hipDeviceGetAttribute(&cus, hipDeviceAttributeMultiprocessorCount, dev);
        if (hipFuncSetAttribute((const void*)fwd_megakernel, hipFuncAttributeMaxDynamicSharedMemorySize, LDS_BYTES) != hipSuccess) { fprintf(stderr, "hipFuncSetAttribute failed\n"); grid = -1; return; }
        if (hipOccupancyMaxActiveBlocksPerMultiprocessor(&per_cu, (const void*)fwd_megakernel, 512, LDS_BYTES) != hipSuccess || per_cu < 1) per_cu = 1;
        (void)hipGetLastError();
        grid = cus * per_cu;
    }
    if (grid < 0) return;
    if (hipMemsetAsync((char*)d_ws + WS_CTL, 0, CTL_BYTES, stream) != hipSuccess) { fprintf(stderr, "memset failed\n"); return; }
    Params p{};
    const float** f = (const float**)&p;
    for (int i = 0; i < 18; ++i) f[i] = (const float*)d_in[i];
    p.out = (float*)d_out; p.ws = (unsigned char*)d_ws; p.ph_lo = 0; p.ph_hi = 10;
    void* args[] = {&p};
    hipError_t e = hipLaunchCooperativeKernel((const void*)fwd_megakernel, dim3(grid), dim3(512), args, LDS_BYTES, stream);
    if (e != hipSuccess) fprintf(stderr, "cooperative launch failed: %s (grid %d)\n", hipGetErrorString(e), grid);
}
```
